# Optimizing an MI355X kernel written in HIP

```python
import jax
import jax.numpy as jnp
from jax import lax
import numpy as np

D_MODEL = 1024
BATCH = 8
SEQ = 2048
DEPTH = 2

GRID_W = 64
CTX_LEN = 256
N_EVEN = (DEPTH + 1) // 2
N_ODD = DEPTH // 2
N_MOD = 6
EPS = 1e-6

RET_HEADS = 4
RET_DK = 64
RET_DV = 128
RET_QK = RET_HEADS * RET_DK
RET_V = RET_HEADS * RET_DV
RET_CHUNK = 128

RWKV_HEADS = 8
RWKV_N = 64
RWKV_W = RWKV_HEADS * RWKV_N
DECAY_RANK = 64
ICLR_RANK = 64
GATE_RANK = 160
GN_EPS = 64e-5
SHIFT_W = 3 * RWKV_W + 2 * DECAY_RANK + 2 * ICLR_RANK + GATE_RANK
EVEN_IN = 2 * RET_QK + 2 * RET_V + SHIFT_W
EVEN_OUT = RET_V + RWKV_W

MLA_HEADS = 8
Q_RANK = 384
KV_RANK = 256
QK_NOPE = 128
QK_ROPE = 64
V_HEAD = 128
ODD_IN = Q_RANK + KV_RANK + QK_ROPE
MLA_SCALE = (QK_NOPE + QK_ROPE) ** -0.5
ROPE_BASE = 10000.0
ATTN_BLOCK = 128

N_GROUPS = 4
EXPERTS_PER_GROUP = 8
N_EXPERTS = N_GROUPS * EXPERTS_PER_GROUP
EXPERT_HIDDEN = 256
TOP_K = 2

kernel_name = 'hybrid_retention_rwkv7_mla_hmoe_dit'


def split_cols(t, sizes):
    return jnp.split(t, np.cumsum(sizes)[:-1].tolist(), axis=-1)


def rmsnorm(x, g):
    xf = x.astype(jnp.float32)
    y = xf * lax.rsqrt(jnp.mean(xf * xf, axis=-1, keepdims=True) + EPS)
    return (y * g).astype(x.dtype)


def modulate(x, shift, scale):
    return x * (1.0 + scale[:, None]) + shift[:, None]


def centred_shift(y, mu):
    prev = jnp.pad(y[:, :-1], ((0, 0), (1, 0), (0, 0)))
    nxt = jnp.pad(y[:, 1:], ((0, 0), (0, 1), (0, 0)))
    return y + mu[0] * (prev - y) + mu[1] * (nxt - y)


def retention_chunkwise(q, k, v, log_gamma, state0):
    b, h, l, dk = q.shape
    dv = v.shape[-1]
    n, cs = l // RET_CHUNK, RET_CHUNK
    qc = q.reshape(b, h, n, cs, dk)
    kc = k.reshape(b, h, n, cs, dk)
    vc = v.reshape(b, h, n, cs, dv)
    pos = jnp.arange(cs, dtype=jnp.float32)
    lg = log_gamma[:, None]
    rel = pos[:, None] - pos[None, :]
    dmask = jnp.where(rel >= 0, jnp.exp(log_gamma[:, None, None] * jnp.maximum(rel, 0.0)), 0.0)
    scores = jnp.einsum('bhnid,bhnjd->bhnij', qc, kc) * dmask[None, :, None]
    o_inner = jnp.einsum('bhnij,bhnjv->bhniv', scores, vc)
    k_dec = jnp.exp(lg * (cs - 1.0 - pos))
    delta = jnp.einsum('bhnjd,bhnjv->nbhdv', kc * k_dec[None, :, None, :, None], vc)
    chunk_decay = jnp.exp(log_gamma * cs)[None, :, None, None]

    def step(s, d):
        return s * chunk_decay + d, s

    s_final, s_prev = lax.scan(step, state0, delta)
    q_dec = jnp.exp(lg * (pos + 1.0))
    o_cross = jnp.einsum('bhnid,nbhdv->bhniv', qc * q_dec[None, :, None, :, None], s_prev)
    return (o_inner + o_cross).reshape(b, h, l, dv), s_final


def bidir_retention(qkv_c, qkv_l, log_gamma):
    qc, kc, vc = qkv_c
    ql, kl, vl = qkv_l
    s0 = jnp.zeros(qc.shape[:2] + (RET_DK, RET_DV), jnp.float32)
    flip = lambda t: jnp.flip(t, axis=2)
    o_cf, s_cf = retention_chunkwise(qc, kc, vc, log_gamma, s0)
    o_lf, _ = retention_chunkwise(ql, kl, vl, log_gamma, s_cf)
    o_cb, s_cb = retention_chunkwise(flip(qc), flip(kc), flip(vc), log_gamma, s0)
    o_lb, _ = retention_chunkwise(flip(ql), flip(kl), flip(vl), log_gamma, s_cb)
    diag = lambda q, k, v: jnp.sum(q * k, axis=-1, keepdims=True) * v
    return (o_cf + flip(o_cb) - diag(qc, kc, vc), o_lf + flip(o_lb) - diag(ql, kl, vl))


def rwkv7_scan(s0, r, w, kk, a, kt, v, reverse):
    def step(s, inp):
        r_t, w_t, kk_t, a_t, k_t, v_t = inp
        sa = jnp.einsum('bhvk,bhk->bhv', s, kk_t)
        s = (s * w_t[:, :, None, :] - sa[..., None] * (kk_t * a_t)[:, :, None, :]
             + v_t[..., None] * k_t[:, :, None, :])
        return s, jnp.einsum('bhvk,bhk->bhv', s, r_t)

    xs = tuple(jnp.swapaxes(t, 0, 1) for t in (r, w, kk, a, kt, v))
    s_final, ys = lax.scan(step, s0, xs, reverse=reverse)
    return jnp.swapaxes(ys, 0, 1), s_final


def bidir_rwkv7(seq_c, seq_l):
    rc, kkc, vc, dc = seq_c
    rl, kkl, vl, dl = seq_l
    s0 = jnp.zeros(rc.shape[:1] + (RWKV_HEADS, RWKV_N, RWKV_N), jnp.float32)
    ys_c, ys_l = [], []
    for direction in range(2):
        rev = direction == 1
        wc, ac, ktc = dc[direction]
        y_c, s_c = rwkv7_scan(s0, rc, wc, kkc, ac, ktc, vc, rev)
        wl, al, ktl = dl[direction]
        y_l, _ = rwkv7_scan(s_c, rl, wl, kkl, al, ktl, vl, rev)
        ys_c.append(y_c)
        ys_l.append(y_l)
    return ys_c[0] + ys_c[1], ys_l[0] + ys_l[1]


def even_mixer(xc, xl, w_in, shift_mu, w0, w2, a0, a2, g2, k_k, k_a, r_k, lnx_w, lnx_b, w_out):
    log_gamma = jnp.log1p(-jnp.exp2(-5.0 - jnp.arange(RET_HEADS, dtype=jnp.float32)))

    def features(x):
        b, l, _ = x.shape
        p = (x @ w_in).astype(jnp.float32)
        q, k, v, g, rw = split_cols(p, [RET_QK, RET_QK, RET_V, RET_V, SHIFT_W])
        to_heads = lambda t: t.reshape(b, l, RET_HEADS, -1).transpose(0, 2, 1, 3)
        ret = (to_heads(q) * RET_DK ** -0.5, to_heads(k), to_heads(v), g)
        rw = centred_shift(rw, shift_mu)
        r, kr, vr, wd_f, wd_b, ad_f, ad_b, gd = split_cols(
            rw, [RWKV_W] * 3 + [DECAY_RANK] * 2 + [ICLR_RANK] * 2 + [GATE_RANK])
        hd = lambda t: t.reshape(b, l, RWKV_HEADS, RWKV_N)
        r, kr, vr = hd(r), hd(kr), hd(vr)
        kk = kr * k_k.reshape(RWKV_HEADS, RWKV_N)
        kk = kk / jnp.maximum(jnp.linalg.norm(kk, axis=-1, keepdims=True), 1e-12)
        dirs = []
        for d, (wd, ad) in enumerate(((wd_f, ad_f), (wd_b, ad_b))):
            wlog = -jax.nn.softplus(-(w0[d] + jnp.tanh(wd) @ w2[d])) - 0.5
            decay = hd(jnp.exp(-jnp.exp(wlog)))
            a = hd(jax.nn.sigmoid(a0[d] + ad @ a2[d]))
            kt = kr * (1.0 + (a - 1.0) * k_a.reshape(RWKV_HEADS, RWKV_N))
            dirs.append((decay, a, kt))
        gate = jax.nn.sigmoid(gd) @ g2
        return ret, (r, kk, vr, dirs, gate)

    def ret_out(o, g):
        o = o * lax.rsqrt(jnp.mean(o * o, axis=-1, keepdims=True) + EPS)
        bb, hh, ll, dv = o.shape
        return o.transpose(0, 2, 1, 3).reshape(bb, ll, hh * dv) * jax.nn.silu(g)

    def rwkv_out(y, feats):
        r, kk, v, dirs, gate = feats
        bb, ll = r.shape[:2]
        mu = jnp.mean(y, axis=-1, keepdims=True)
        var = jnp.mean(jnp.square(y - mu), axis=-1, keepdims=True)
        yn = ((y - mu) * lax.rsqrt(var + GN_EPS) * lnx_w.reshape(RWKV_HEADS, RWKV_N)
              + lnx_b.reshape(RWKV_HEADS, RWKV_N))
        bonus = jnp.sum(r * (dirs[0][2] + dirs[1][2]) * r_k, axis=-1, keepdims=True) * v
        return (yn + bonus).reshape(bb, ll, RWKV_W) * gate

    (qc, kc, vc, gc), rwc = features(xc)
    (ql, kl, vl, gl), rwl = features(xl)
    oc, ol = bidir_retention((qc, kc, vc), (ql, kl, vl), log_gamma)
    yc, yl = bidir_rwkv7(rwc[:4], rwl[:4])
    out_c = jnp.concatenate([ret_out(oc, gc), rwkv_out(yc, rwc)], axis=-1).astype(xc.dtype) @ w_out
    out_l = jnp.concatenate([ret_out(ol, gl), rwkv_out(yl, rwl)], axis=-1).astype(xl.dtype) @ w_out
    return out_c, out_l


def axial_rope_angles(length):
    rows = length // GRID_W
    row = jnp.repeat(jnp.arange(rows, dtype=jnp.float32), GRID_W)
    col = jnp.tile(jnp.arange(GRID_W, dtype=jnp.float32), rows)
    n_freq = QK_ROPE // 4
    inv_freq = ROPE_BASE ** (-jnp.arange(n_freq, dtype=jnp.float32) / n_freq)
    return row[:, None] * inv_freq, col[:, None] * inv_freq


def rotate_half_axis(t, ang):
    cos = jnp.cos(ang)[None, :, None, :]
    sin = jnp.sin(ang)[None, :, None, :]
    t1, t2 = jnp.split(t, 2, axis=-1)
    return jnp.concatenate([t1 * cos - t2 * sin, t2 * cos + t1 * sin], axis=-1)


def apply_axial_rope(t, ang_row, ang_col):
    half = t.shape[-1] // 2
    out = jnp.concatenate([rotate_half_axis(t[..., :half], ang_row),
                           rotate_half_axis(t[..., half:], ang_col)], axis=-1)
    return out.astype(t.dtype)


def softmax_attention(q, k, v):
    s = jnp.einsum('bqhd,bkhd->bhqk', q, k).astype(jnp.float32) * MLA_SCALE
    p = jax.nn.softmax(s, axis=-1).astype(v.dtype)
    return jnp.einsum('bhqk,bkhd->bqhd', p, v)


def blocked_attention(q, k, v):
    b, l, h, d = q.shape
    qb = jnp.swapaxes(q.reshape(b, l // ATTN_BLOCK, ATTN_BLOCK, h, d), 0, 1)
    ob = lax.map(lambda blk: softmax_attention(blk, k, v), qb)
    return jnp.swapaxes(ob, 0, 1).reshape(b, l, h, v.shape[-1])


def mla_mixer(xc, xl, w_in, q_norm_g, w_uq, kv_norm_g, w_ukv, w_o, need_ctx):
    b, l, _ = xl.shape
    ang_r, ang_c = axial_rope_angles(l)

    def project_q(x, rotate):
        bb, ll, _ = x.shape
        c_q = rmsnorm(x @ w_in[:, :Q_RANK], q_norm_g)
        q = (c_q @ w_uq).reshape(bb, ll, MLA_HEADS, QK_NOPE + QK_ROPE)
        q_nope, q_pe = q[..., :QK_NOPE], q[..., QK_NOPE:]
        if rotate:
            q_pe = apply_axial_rope(q_pe, ang_r, ang_c)
        return jnp.concatenate([q_nope, q_pe], axis=-1)

    def project_kv(x, rotate):
        bb, ll, _ = x.shape
        kv_a = x @ w_in[:, Q_RANK:]
        c_kv = rmsnorm(kv_a[..., :KV_RANK], kv_norm_g)
        k_pe = kv_a[..., KV_RANK:][:, :, None, :]
        if rotate:
            k_pe = apply_axial_rope(k_pe, ang_r, ang_c)
        kv = (c_kv @ w_ukv).reshape(bb, ll, MLA_HEADS, QK_NOPE + V_HEAD)
        k = jnp.concatenate([kv[..., :QK_NOPE],
                             jnp.broadcast_to(k_pe, (bb, ll, MLA_HEADS, QK_ROPE))], axis=-1)
        return k, kv[..., QK_NOPE:]

    kc, vc = project_kv(xc, False)
    kl, vl = project_kv(xl, True)
    ql = project_q(xl, True)
    k_all = jnp.concatenate([kc, kl], axis=1)
    v_all = jnp.concatenate([vc, vl], axis=1)
    out_l = blocked_attention(ql, k_all, v_all).reshape(b, l, MLA_HEADS * V_HEAD) @ w_o
    out_c = None
    if need_ctx:
        qc = project_q(xc, False)
        out_c = softmax_attention(qc, kc, vc).reshape(b, xc.shape[1], MLA_HEADS * V_HEAD) @ w_o
    return out_c, out_l


def hier_moe(x, w_grp, b_grp, w_exp, b_exp, w_gate, w_up, w_down):
    xf = x.astype(jnp.float32)
    p_grp = jax.nn.softmax(xf @ w_grp.astype(jnp.float32) + b_grp.astype(jnp.float32), axis=-1)
    pg, g_idx = lax.top_k(p_grp, 1)
    e_logits = (xf @ w_exp.astype(jnp.float32) + b_exp.astype(jnp.float32)).reshape(
        -1, N_GROUPS, EXPERTS_PER_GROUP)
    e_sel = jnp.einsum('tg,tge->te', jax.nn.one_hot(g_idx[:, 0], N_GROUPS, dtype=jnp.float32), e_logits)
    pe, e_idx = lax.top_k(jax.nn.softmax(e_sel, axis=-1), TOP_K)
    wts = pg * pe / jnp.sum(pe, axis=-1, keepdims=True)
    flat = g_idx * EXPERTS_PER_GROUP + e_idx
    gates = jnp.einsum('tk,tke->te', wts, jax.nn.one_hot(flat, N_EXPERTS, dtype=jnp.float32)).astype(x.dtype)
    y = jnp.zeros_like(x)
    for e in range(N_EXPERTS):
        hidden = jax.nn.silu(x @ w_gate[e]) * (x @ w_up[e])
        y = y + gates[:, e:e + 1] * (hidden @ w_down[e])
    return y


def setup_inputs(seed: int = 0) -> dict:
    key = jax.random.key(seed)
    keys = iter(jax.random.split(key, 40))

    def normal(shape, scale):
        return jax.random.normal(next(keys), shape, jnp.float32) * scale

    def uniform(shape, lo, hi):
        return jax.random.uniform(next(keys), shape, jnp.float32, lo, hi)

    def gain(shape):
        return 1.0 + normal(shape, 0.05)

    d = D_MODEL
    return {
        'x': normal((BATCH, SEQ, d), 1.0),
        'c': normal((BATCH, d), 1.0),
        'ctx': normal((BATCH, CTX_LEN, d), 1.0),
        'c_ctx': normal((d,), 1.0),
        'ada_w': normal((DEPTH, d, N_MOD * d), 0.5 * d ** -0.5),
        'ada_b': normal((DEPTH, N_MOD * d), 0.02),
        'norm1_g': gain((DEPTH, d)),
        'norm2_g': gain((DEPTH, d)),
        'final_g': gain((d,)),
        'ev_w_in': normal((N_EVEN, d, EVEN_IN), d ** -0.5),
        'ev_shift_mu': uniform((N_EVEN, 2, SHIFT_W), 0.0, 0.5),
        'rwkv_w0': uniform((N_EVEN, 2, RWKV_W), -6.0, 0.0),
        'rwkv_w2': normal((N_EVEN, 2, DECAY_RANK, RWKV_W), 0.5 * DECAY_RANK ** -0.5),
        'rwkv_a0': normal((N_EVEN, 2, RWKV_W), 0.5),
        'rwkv_a2': normal((N_EVEN, 2, ICLR_RANK, RWKV_W), 0.5 * ICLR_RANK ** -0.5),
        'rwkv_g2': normal((N_EVEN, GATE_RANK, RWKV_W), GATE_RANK ** -0.5),
        'rwkv_k_k': 0.85 + normal((N_EVEN, RWKV_W), 0.1),
        'rwkv_k_a': uniform((N_EVEN, RWKV_W), 0.5, 1.0),
        'rwkv_r_k': normal((N_EVEN, RWKV_HEADS, RWKV_N), 0.1),
        'rwkv_lnx_w': gain((N_EVEN, RWKV_W)),
        'rwkv_lnx_b': normal((N_EVEN, RWKV_W), 0.02),
        'ev_w_out': normal((N_EVEN, EVEN_OUT, d), EVEN_OUT ** -0.5),
        'mla_w_in': normal((N_ODD, d, ODD_IN), d ** -0.5),
        'mla_q_norm_g': gain((N_ODD, Q_RANK)),
        'mla_w_uq': normal((N_ODD, Q_RANK, MLA_HEADS * (QK_NOPE + QK_ROPE)), Q_RANK ** -0.5),
        'mla_kv_norm_g': gain((N_ODD, KV_RANK)),
        'mla_w_ukv': normal((N_ODD, KV_RANK, MLA_HEADS * (QK_NOPE + V_HEAD)), KV_RANK ** -0.5),
        'mla_w_o': normal((N_ODD, MLA_HEADS * V_HEAD, d), (MLA_HEADS * V_HEAD) ** -0.5),
        'moe_w_grp': normal((DEPTH, d, N_GROUPS), d ** -0.5),
        'moe_b_grp': normal((DEPTH, N_GROUPS), 0.01),
        'moe_w_exp': normal((DEPTH, d, N_EXPERTS), d ** -0.5),
        'moe_b_exp': normal((DEPTH, N_EXPERTS), 0.01),
        'moe_w_gate': normal((DEPTH, N_EXPERTS, d, EXPERT_HIDDEN), d ** -0.5),
        'moe_w_up': normal((DEPTH, N_EXPERTS, d, EXPERT_HIDDEN), d ** -0.5),
        'moe_w_down': normal((DEPTH, N_EXPERTS, EXPERT_HIDDEN, d), EXPERT_HIDDEN ** -0.5),
    }


def reference(x, c, ctx, c_ctx, ada_w, ada_b, norm1_g, norm2_g, final_g,
              ev_w_in, ev_shift_mu, rwkv_w0, rwkv_w2, rwkv_a0, rwkv_a2, rwkv_g2,
              rwkv_k_k, rwkv_k_a, rwkv_r_k, rwkv_lnx_w, rwkv_lnx_b, ev_w_out,
              mla_w_in, mla_q_norm_g, mla_w_uq, mla_kv_norm_g, mla_w_ukv, mla_w_o,
              moe_w_grp, moe_b_grp, moe_w_exp, moe_b_exp, moe_w_gate, moe_w_up, moe_w_down):
    b, l, d = x.shape
    lc = ctx.shape[1]
    h, hc = x, ctx
    s_lat = jax.nn.silu(c)
    s_ctx = jax.nn.silu(c_ctx)[None]
    for layer in range(DEPTH):
        last = layer == DEPTH - 1
        i = layer // 2
        m = jnp.split(s_lat @ ada_w[layer] + ada_b[layer], N_MOD, axis=-1)
        mc = jnp.split(s_ctx @ ada_w[layer] + ada_b[layer], N_MOD, axis=-1)
        xl = modulate(rmsnorm(h, norm1_g[layer]), m[0], m[1])
        xc = modulate(rmsnorm(hc, norm1_g[layer]), mc[0], mc[1])
        if layer % 2 == 0:
            yc, yl = even_mixer(xc, xl, ev_w_in[i], ev_shift_mu[i], rwkv_w0[i], rwkv_w2[i],
                                rwkv_a0[i], rwkv_a2[i], rwkv_g2[i], rwkv_k_k[i], rwkv_k_a[i],
                                rwkv_r_k[i], rwkv_lnx_w[i], rwkv_lnx_b[i], ev_w_out[i])
        else:
            yc, yl = mla_mixer(xc, xl, mla_w_in[i], mla_q_norm_g[i], mla_w_uq[i],
                               mla_kv_norm_g[i], mla_w_ukv[i], mla_w_o[i], not last)
        h = h + m[2][:, None] * yl
        xl = modulate(rmsnorm(h, norm2_g[layer]), m[3], m[4])

        def channel_mix(t):
            return hier_moe(t, moe_w_grp[layer], moe_b_grp[layer], moe_w_exp[layer], moe_b_exp[layer],
                            moe_w_gate[layer], moe_w_up[layer], moe_w_down[layer])

        if last:
            h = h + m[5][:, None] * channel_mix(xl.reshape(b * l, d)).reshape(b, l, d)
        else:
            hc = hc + mc[2][:, None] * yc
            xc = modulate(rmsnorm(hc, norm2_g[layer]), mc[3], mc[4])
            y = channel_mix(jnp.concatenate([xc.reshape(b * lc, d), xl.reshape(b * l, d)], axis=0))
            hc = hc + mc[5][:, None] * y[: b * lc].reshape(b, lc, d)
            h = h + m[5][:, None] * y[b * lc:].reshape(b, l, d)
    return rmsnorm(h, final_g)
```

```cpp
#ifndef HOST_EMU
#include <hip/hip_runtime.h>
#define DEVFN __device__ __forceinline__
#define DEVNI __device__
#else
#include <cmath>
#include <cstdio>
#include <cstdlib>
#include <cstring>
#include <cstdint>
#define DEVFN inline
#define DEVNI
#define __global__
typedef void* hipStream_t;
static inline float rsqrtf(float x) { return 1.0f / sqrtf(x); }
#endif
#include <cstddef>

#ifndef NB
#define NB 8
#endif
#ifndef NL
#define NL 2048
#endif
#ifndef NC
#define NC 256
#endif

typedef unsigned short bf16_t;

constexpr int D = 1024;
constexpr int SQ = NC + NL;
constexpr int TC = NB * NC;
constexpr int TL = NB * NL;
constexpr int T = TC + TL;
constexpr int EVEN_IN = 3488, SHIFT_W = 1952, NRET = 1536, NLIN = 416;
constexpr int NMOD = 6 * D;
constexpr float EPS = 1e-6f, GN_EPS = 64e-5f;

DEVFN float bf2f(bf16_t v) { unsigned u = ((unsigned)v) << 16; float f; memcpy(&f, &u, 4); return f; }
DEVFN bf16_t f2bf(float f) { unsigned u; memcpy(&u, &f, 4); u += 0x7FFFu + ((u >> 16) & 1u); return (bf16_t)(u >> 16); }
DEVFN float sigmoidf_(float x) { return 1.0f / (1.0f + expf(-x)); }
DEVFN float siluf_(float x) { return x / (1.0f + expf(-x)); }

struct Params {
    const float *x, *c, *ctx, *c_ctx, *ada_w, *ada_b, *norm1_g, *norm2_g, *final_g;
    const float *ev_w_in, *ev_shift_mu, *rwkv_w0, *rwkv_w2, *rwkv_a0, *rwkv_a2, *rwkv_g2, *rwkv_k_k, *rwkv_k_a, *rwkv_r_k, *rwkv_lnx_w, *rwkv_lnx_b, *ev_w_out;
    const float *mla_w_in, *mla_q_norm_g, *mla_w_uq, *mla_kv_norm_g, *mla_w_ukv, *mla_w_o;
    const float *moe_w_grp, *moe_b_grp, *moe_w_exp, *moe_b_exp, *moe_w_gate, *moe_w_up, *moe_w_down;
    float* out;
    float* mod;
    int* eidx;
    float* ew;
    float* bonus;
    float* hctx;
    bf16_t* xn;
    bf16_t *fr, *fkk;
    bf16_t* mix;
    bf16_t* pret;
    bf16_t* prw;
    bf16_t* lin;
    float *ro, *yb;
    bf16_t *fv, *fomw0, *fomw1, *fkka0, *fkka1, *fkt0, *fkt1, *fgate;
    bf16_t* hid;
    float* qkva;
    bf16_t *cq, *ckv, *kpe;
    float* qraw;
    bf16_t* qb;
    bf16_t* kvb;
    float* sc;
    bf16_t* ao;
};

DEVFN float* hrow(const Params& p, int tk) { return tk < TC ? p.hctx + (size_t)tk * D : p.out + (size_t)(tk - TC) * D; }
DEVFN int modrow(int tk) { return tk < TC ? NB : (tk - TC) / NL; }
DEVFN const float* modp(const Params& p, int layer, int mr, int which) { return p.mod + (((size_t)layer * (NB + 1) + mr) * 6 + which) * D; }
DEVFN int scan_tok(int b, int dir, int step) {
    if (step < NC) return b * NC + (dir ? NC - 1 - step : step);
    const int t = step - NC; return TC + b * NL + (dir ? NL - 1 - t : t);
}
DEVFN int key_tok(int b, int key) { return key < NC ? b * NC + key : TC + b * NL + (key - NC); }

DEVNI void ph_init(const Params& p, size_t g, size_t gs) {
    for (size_t i = g; i < (size_t)T * D; i += gs) { if (i < (size_t)TC * D) p.hctx[i] = p.ctx[i]; else p.out[i - (size_t)TC * D] = p.x[i - (size_t)TC * D]; }
}
DEVNI void ph_mod(const Params& p, size_t g, size_t gs) {
    for (size_t i = g; i < (size_t)2 * NMOD; i += gs) {
        const int l = (int)(i / NMOD), n = (int)(i % NMOD);
        float acc[NB + 1];
#pragma unroll
        for (int r = 0; r <= NB; ++r) acc[r] = 0.f;
        for (int k = 0; k < D; ++k) {
            const float w = p.ada_w[((size_t)l * D + k) * NMOD + n];
#pragma unroll
            for (int r = 0; r < NB; ++r) acc[r] += siluf_(p.c[r * D + k]) * w;
            acc[NB] += siluf_(p.c_ctx[k]) * w;
        }
#pragma unroll
        for (int r = 0; r <= NB; ++r) p.mod[((size_t)l * (NB + 1) + r) * NMOD + n] = acc[r] + p.ada_b[(size_t)l * NMOD + n];
    }
}
DEVNI void ph_norm(const Params& p, int layer, int which  , int t0, size_t g, size_t gs) {
    const float* gain = (which == 1 ? p.norm1_g : p.norm2_g) + (size_t)layer * D;
    const int si = which == 1 ? 0 : 3, ci = si + 1;
    for (size_t it = g; it < (size_t)(T - t0); it += gs) {
        const int tk = t0 + (int)it; const float* h = hrow(p, tk);
        float ss = 0.f; for (int k = 0; k < D; ++k) ss += h[k] * h[k];
        const float rstd = rsqrtf(ss / D + EPS);
        const int mr = modrow(tk); const float* sh = modp(p, layer, mr, si); const float* sc = modp(p, layer, mr, ci);
        if (which == 1) {
            for (int k = 0; k < D; ++k) { const float v = (h[k] * rstd * gain[k]) * (1.0f + sc[k]) + sh[k]; p.xn[(size_t)tk * D + k] = f2bf(v); }
        } else {
            float lg[4], le[32];
#pragma unroll
            for (int j = 0; j < 4; ++j) lg[j] = p.moe_b_grp[layer * 4 + j];
#pragma unroll
            for (int j = 0; j < 32; ++j) le[j] = p.moe_b_exp[layer * 32 + j];
            const float* wg = p.moe_w_grp + (size_t)layer * D * 4; const float* we = p.moe_w_exp + (size_t)layer * D * 32;
            for (int k = 0; k < D; ++k) {
                const float v = (h[k] * rstd * gain[k]) * (1.0f + sc[k]) + sh[k]; p.xn[(size_t)tk * D + k] = f2bf(v);
#pragma unroll
                for (int j = 0; j < 4; ++j) lg[j] += v * wg[k * 4 + j];
#pragma unroll
                for (int j = 0; j < 32; ++j) le[j] += v * we[k * 32 + j];
            }
            int gi = 0; float gm = lg[0];
#pragma unroll
            for (int j = 1; j < 4; ++j) if (lg[j] > gm) { gm = lg[j]; gi = j; }
            float gz = 0.f;
#pragma unroll
            for (int j = 0; j < 4; ++j) gz += expf(lg[j] - gm);
            const float pg = 1.0f / gz;
            float es[8];
#pragma unroll
            for (int j = 0; j < 8; ++j) es[j] = gi == 0 ? le[j] : gi == 1 ? le[8 + j] : gi == 2 ? le[16 + j] : le[24 + j];
            int i1 = 0; float e1 = es[0];
#pragma unroll
            for (int j = 1; j < 8; ++j) if (es[j] > e1) { e1 = es[j]; i1 = j; }
            int i2 = -1; float e2 = -3.0e38f;
#pragma unroll
            for (int j = 0; j < 8; ++j) if (j != i1 && es[j] > e2) { e2 = es[j]; i2 = j; }
            const float r = expf(e2 - e1), inv = 1.0f / (1.0f + r);
            p.eidx[tk * 2 + 0] = gi * 8 + i1; p.eidx[tk * 2 + 1] = gi * 8 + i2;
            p.ew[tk * 2 + 0] = pg * inv; p.ew[tk * 2 + 1] = pg * r * inv;
        }
    }
}
template <class Epi>
DEVFN void gemm_naive(const bf16_t* A, int lda, const float* W, int ldw, int row0, int M, int N, int K, Epi epi, size_t g, size_t gs) {
    for (size_t i = g; i < (size_t)M * N; i += gs) {
        const int m = row0 + (int)(i / N), n = (int)(i % N);
        const bf16_t* a = A + (size_t)m * lda; float acc = 0.f;
        for (int k = 0; k < K; ++k) acc += bf2f(a[k]) * W[(size_t)k * ldw + n];
        epi(m, n, acc);
    }
}
DEVNI void ph_gemm_evin(const Params& p, size_t g, size_t gs) {
    gemm_naive(p.xn, D, p.ev_w_in, EVEN_IN, 0, T, EVEN_IN, D, [&](int m, int n, float v) {
        if (n < NRET) p.pret[(size_t)m * NRET + n] = f2bf(n < 256 ? v * 0.125f : v); else p.prw[(size_t)m * SHIFT_W + (n - NRET)] = f2bf(v); }, g, gs);
}
DEVFN float shifted(const Params& p, int tk, int col) {
    int pos, len; if (tk < TC) { pos = tk % NC; len = NC; } else { pos = (tk - TC) % NL; len = NL; }
    const float y = bf2f(p.prw[(size_t)tk * SHIFT_W + col]);
    const float pv = pos > 0 ? bf2f(p.prw[(size_t)(tk - 1) * SHIFT_W + col]) : 0.f;
    const float nx = pos < len - 1 ? bf2f(p.prw[(size_t)(tk + 1) * SHIFT_W + col]) : 0.f;
    return y + p.ev_shift_mu[col] * (pv - y) + p.ev_shift_mu[SHIFT_W + col] * (nx - y);
}
DEVNI void ph_feat_a(const Params& p, size_t g, size_t gs) {
    for (size_t i = g; i < (size_t)T * NLIN; i += gs) {
        const int tk = (int)(i / NLIN), j = (int)(i % NLIN);
        const float s = shifted(p, tk, 1536 + j);
        const float v = j < 128 ? tanhf(s) : j < 256 ? s : sigmoidf_(s);
        p.lin[i] = f2bf(v);
    }
}
DEVNI void ph_feat_b(const Params& p, size_t g, size_t gs) {
    for (size_t i = g; i < (size_t)T * 512; i += gs) {
        const int tk = (int)(i / 512), c = (int)(i % 512), h0 = c & ~63;
        const float r = shifted(p, tk, c), kr = shifted(p, tk, 512 + c), vr = shifted(p, tk, 1024 + c);
        float n2 = 0.f;
        for (int j = 0; j < 64; ++j) { const float t = shifted(p, tk, 512 + h0 + j) * p.rwkv_k_k[h0 + j]; n2 += t * t; }
        const float kk = kr * p.rwkv_k_k[c] / fmaxf(sqrtf(n2), 1e-12f);
        const bf16_t* li = p.lin + (size_t)tk * NLIN;
#pragma unroll
        for (int d = 0; d < 2; ++d) {
            bf16_t* omw = d ? p.fomw1 : p.fomw0; bf16_t* kka = d ? p.fkka1 : p.fkka0; bf16_t* kt = d ? p.fkt1 : p.fkt0;
            float lw = p.rwkv_w0[d * 512 + c], la = p.rwkv_a0[d * 512 + c];
            for (int j = 0; j < 64; ++j) { lw += bf2f(li[d * 64 + j]) * p.rwkv_w2[((size_t)d * 64 + j) * 512 + c]; la += bf2f(li[128 + d * 64 + j]) * p.rwkv_a2[((size_t)d * 64 + j) * 512 + c]; }
            const float xs = -lw; const float sp = xs > 20.f ? xs : log1pf(expf(xs));
            const float e = expf(-sp - 0.5f);
            const float a = sigmoidf_(la);
            omw[i] = f2bf(-expm1f(-e));
            kka[i] = f2bf(kk * a);
            kt[i] = f2bf(kr * (1.0f + (a - 1.0f) * p.rwkv_k_a[c]));
        }
        float gt = 0.f; for (int j = 0; j < 160; ++j) gt += bf2f(li[256 + j]) * p.rwkv_g2[(size_t)j * 512 + c];
        p.fr[i] = f2bf(r); p.fkk[i] = f2bf(kk); p.fv[i] = f2bf(vr); p.fgate[i] = f2bf(gt);
    }
}
DEVNI void ph_bonus(const Params& p, size_t g, size_t gs) {
    for (size_t i = g; i < (size_t)T * 8; i += gs) {
        const size_t base = i * 64; const int h = (int)(i % 8); float s = 0.f;
        for (int j = 0; j < 64; ++j) s += bf2f(p.fr[base + j]) * (bf2f(p.fkt0[base + j]) + bf2f(p.fkt1[base + j])) * p.rwkv_r_k[h * 64 + j];
        p.bonus[i] = s;
    }
}
DEVNI void ph_ret_scan(const Params& p, int dir, size_t g, size_t gs) {
    for (size_t it = g; it < (size_t)NB * 4 * 128; it += gs) {
        const int v = (int)(it % 128), h = (int)((it / 128) % 4), b = (int)(it / 512);
        const float gamma = 1.0f - exp2f(-5.0f - (float)h);
        float S[64];
#pragma unroll
        for (int i = 0; i < 64; ++i) S[i] = 0.f;
        for (int step = 0; step < SQ; ++step) {
            const int tk = scan_tok(b, dir, step);
            const bf16_t* row = p.pret + (size_t)tk * NRET;
            const float vt = bf2f(row[512 + h * 128 + v]);
            float o = 0.f, dg = 0.f;
#pragma unroll
            for (int i = 0; i < 64; ++i) { const float q = bf2f(row[h * 64 + i]), k = bf2f(row[256 + h * 64 + i]); S[i] = gamma * S[i] + k * vt; o += q * S[i]; dg += q * k; }
            float* dst = p.ro + (size_t)tk * 512 + h * 128 + v;
            if (dir == 0) *dst = o; else *dst += o - dg * vt;
        }
    }
}
DEVNI void ph_rwkv_scan(const Params& p, int dir, size_t g, size_t gs) {
    const bf16_t* omw = dir ? p.fomw1 : p.fomw0; const bf16_t* kka = dir ? p.fkka1 : p.fkka0; const bf16_t* kt = dir ? p.fkt1 : p.fkt0;
    for (size_t it = g; it < (size_t)NB * 8 * 64; it += gs) {
        const int v = (int)(it % 64), h = (int)((it / 64) % 8), b = (int)(it / 512);
        float S[64];
#pragma unroll
        for (int k = 0; k < 64; ++k) S[k] = 0.f;
        for (int step = 0; step < SQ; ++step) {
            const int tk = scan_tok(b, dir, step); const size_t base = (size_t)tk * 512 + h * 64;
            const float vt = bf2f(p.fv[base + v]);
            float sa = 0.f;
#pragma unroll
            for (int k = 0; k < 64; ++k) sa += S[k] * bf2f(p.fkk[base + k]);
            float y = 0.f;
#pragma unroll
            for (int k = 0; k < 64; ++k) { const float w = 1.0f - bf2f(omw[base + k]); S[k] = S[k] * w - sa * bf2f(kka[base + k]) + vt * bf2f(kt[base + k]); y += S[k] * bf2f(p.fr[base + k]); }
            float* dst = p.yb + base + v;
            if (dir == 0) *dst = y; else *dst += y;
        }
    }
}
DEVNI void ph_mixout(const Params& p, size_t g, size_t gs) {
    for (size_t it = g; it < (size_t)T * 12; it += gs) {
        const int tk = (int)(it / 12), u = (int)(it % 12);
        if (u < 4) {
            const float* o = p.ro + (size_t)tk * 512 + u * 128; float ms = 0.f;
            for (int j = 0; j < 128; ++j) ms += o[j] * o[j];
            const float rs = rsqrtf(ms / 128.f + EPS);
            for (int j = 0; j < 128; ++j) { const float gg = bf2f(p.pret[(size_t)tk * NRET + 1024 + u * 128 + j]); p.mix[(size_t)tk * D + u * 128 + j] = f2bf(o[j] * rs * siluf_(gg)); }
        } else {
            const int h = u - 4; const size_t base = (size_t)tk * 512 + h * 64; const float* y = p.yb + base;
            float mu = 0.f; for (int j = 0; j < 64; ++j) mu += y[j]; mu /= 64.f;
            float var = 0.f; for (int j = 0; j < 64; ++j) { const float d = y[j] - mu; var += d * d; } var /= 64.f;
            const float rs = rsqrtf(var + GN_EPS), bn = p.bonus[(size_t)tk * 8 + h];
            for (int j = 0; j < 64; ++j) { const int c = h * 64 + j;
                const float yn = (y[j] - mu) * rs * p.rwkv_lnx_w[c] + p.rwkv_lnx_b[c];
                p.mix[(size_t)tk * D + 512 + c] = f2bf((yn + bn * bf2f(p.fv[base + j])) * bf2f(p.fgate[base + j])); }
        }
    }
}
DEVNI void ph_gemm_res(const Params& p, const bf16_t* A, const float* W, int layer, int row0, size_t g, size_t gs) {
    gemm_naive(A, D, W, D, row0, T - row0, D, D, [&](int m, int n, float v) { hrow(p, m)[n] += modp(p, layer, modrow(m), 2)[n] * v; }, g, gs);
}
DEVNI void ph_moe_hidden(const Params& p, int layer, int t0, size_t g, size_t gs) {
    for (size_t i = g; i < (size_t)(T - t0) * 512; i += gs) {
        const int tk = t0 + (int)(i / 512), slot = (int)((i / 256) % 2), j = (int)(i % 256);
        const int e = p.eidx[tk * 2 + slot];
        const float* wg = p.moe_w_gate + ((size_t)(layer * 32 + e) * D) * 256 + j; const float* wu = p.moe_w_up + ((size_t)(layer * 32 + e) * D) * 256 + j;
        const bf16_t* a = p.xn + (size_t)tk * D; float gg = 0.f, uu = 0.f;
        for (int k = 0; k < D; ++k) { const float xv = bf2f(a[k]); gg += xv * wg[(size_t)k * 256]; uu += xv * wu[(size_t)k * 256]; }
        p.hid[((size_t)tk * 2 + slot) * 256 + j] = f2bf(siluf_(gg) * uu);
    }
}
DEVNI void ph_moe_out(const Params& p, int layer, int t0, size_t g, size_t gs) {
    for (size_t i = g; i < (size_t)(T - t0) * D; i += gs) {
        const int tk = t0 + (int)(i / D), n = (int)(i % D); float y = 0.f;
        for (int slot = 0; slot < 2; ++slot) {
            const int e = p.eidx[tk * 2 + slot]; const float* wd = p.moe_w_down + ((size_t)(layer * 32 + e) * 256) * D + n;
            const bf16_t* hh = p.hid + ((size_t)tk * 2 + slot) * 256; float s = 0.f;
            for (int j = 0; j < 256; ++j) s += bf2f(hh[j]) * wd[(size_t)j * D];
            y += p.ew[tk * 2 + slot] * s;
        }
        hrow(p, tk)[n] += modp(p, layer, modrow(tk), 5)[n] * y;
    }
}
DEVNI void ph_gemm_mlain(const Params& p, size_t g, size_t gs) {
    gemm_naive(p.xn, D, p.mla_w_in, 704, 0, T, 704, D, [&](int m, int n, float v) { p.qkva[(size_t)m * 704 + n] = v; }, g, gs);
}
DEVFN float rope_elem(const float* u, int t, int k) {
    const int row = t / 64, col = t % 64, hf = k >> 5, kk = k & 31, i = kk & 15;
    const float pos = (float)(hf ? col : row), inv = powf(10000.0f, -(float)i / 16.0f), ang = pos * inv, cs = cosf(ang), sn = sinf(ang);
    const float t1 = u[hf * 32 + i], t2 = u[hf * 32 + 16 + i];
    return kk < 16 ? t1 * cs - t2 * sn : t2 * cs + t1 * sn;
}
DEVNI void ph_mla_norm(const Params& p, size_t g, size_t gs) {
    for (size_t it = g; it < (size_t)T; it += gs) {
        const int tk = (int)it; const float* a = p.qkva + (size_t)tk * 704;
        float s1 = 0.f; for (int k = 0; k < 384; ++k) s1 += a[k] * a[k];
        const float r1 = rsqrtf(s1 / 384.f + EPS);
        for (int k = 0; k < 384; ++k) p.cq[(size_t)tk * 384 + k] = f2bf(a[k] * r1 * p.mla_q_norm_g[k]);
        float s2 = 0.f; for (int k = 0; k < 256; ++k) s2 += a[384 + k] * a[384 + k];
        const float r2 = rsqrtf(s2 / 256.f + EPS);
        for (int k = 0; k < 256; ++k) p.ckv[(size_t)tk * 256 + k] = f2bf(a[384 + k] * r2 * p.mla_kv_norm_g[k]);
        if (tk < TC) { for (int k = 0; k < 64; ++k) p.kpe[(size_t)tk * 64 + k] = f2bf(a[640 + k]); }
        else { for (int k = 0; k < 64; ++k) p.kpe[(size_t)tk * 64 + k] = f2bf(rope_elem(a + 640, (tk - TC) % NL, k)); }
    }
}
DEVNI void ph_gemm_uq(const Params& p, size_t g, size_t gs) {
    gemm_naive(p.cq, 384, p.mla_w_uq, 1536, TC, TL, 1536, 384, [&](int m, int n, float v) { p.qraw[(size_t)(m - TC) * 1536 + n] = v; }, g, gs);
}
DEVNI void ph_qrope(const Params& p, size_t g, size_t gs) {
    for (size_t it = g; it < (size_t)TL * 8; it += gs) {
        const int tl = (int)(it / 8), h = (int)(it % 8); const float* q = p.qraw + (size_t)tl * 1536 + h * 192; bf16_t* o = p.qb + (size_t)tl * 1536 + h * 192;
        for (int k = 0; k < 128; ++k) o[k] = f2bf(q[k]);
        for (int k = 0; k < 64; ++k) o[128 + k] = f2bf(rope_elem(q + 128, tl % NL, k));
    }
}
DEVNI void ph_gemm_ukv(const Params& p, size_t g, size_t gs) {
    gemm_naive(p.ckv, 256, p.mla_w_ukv, 2048, 0, T, 2048, 256, [&](int m, int n, float v) { p.kvb[(size_t)m * 2048 + n] = f2bf(v); }, g, gs);
}
DEVNI void ph_scores(const Params& p, int b, size_t g, size_t gs) {
    const float scale = 0.07216878364870322f;
    for (size_t i = g; i < (size_t)8 * NL * SQ; i += gs) {
        const int key = (int)(i % SQ), ql = (int)((i / SQ) % NL), h = (int)(i / ((size_t)SQ * NL));
        const bf16_t* q = p.qb + ((size_t)(b * NL + ql) * 8 + h) * 192; const int tkk = key_tok(b, key);
        const bf16_t* kn = p.kvb + (size_t)tkk * 2048 + h * 256; const bf16_t* kp = p.kpe + (size_t)tkk * 64; float s = 0.f;
        for (int d = 0; d < 128; ++d) s += bf2f(q[d]) * bf2f(kn[d]);
        for (int d = 0; d < 64; ++d) s += bf2f(q[128 + d]) * bf2f(kp[d]);
        p.sc[i] = s * scale;
    }
}
DEVNI void ph_softmax(const Params& p, size_t g, size_t gs) {
    for (size_t it = g; it < (size_t)8 * NL; it += gs) {
        float* s = p.sc + it * SQ; float m = s[0]; for (int k = 1; k < SQ; ++k) m = fmaxf(m, s[k]);
        float z = 0.f; for (int k = 0; k < SQ; ++k) { const float e = expf(s[k] - m); s[k] = e; z += e; }
        const float inv = 1.0f / z; for (int k = 0; k < SQ; ++k) s[k] *= inv;
    }
}
DEVNI void ph_pv(const Params& p, int b, size_t g, size_t gs) {
    for (size_t i = g; i < (size_t)NL * D; i += gs) {
        const int ql = (int)(i / D), c = (int)(i % D), h = c / 128, d = c % 128;
        const float* pr = p.sc + ((size_t)h * NL + ql) * SQ; float o = 0.f;
        for (int key = 0; key < SQ; ++key) o += pr[key] * bf2f(p.kvb[(size_t)key_tok(b, key) * 2048 + h * 256 + 128 + d]);
        p.ao[(size_t)(b * NL + ql) * D + c] = f2bf(o);
    }
}
DEVNI void ph_gemm_wo(const Params& p, size_t g, size_t gs) {
    gemm_naive(p.ao, D, p.mla_w_o, D, 0, TL, D, D, [&](int m, int n, float v) { p.out[(size_t)m * D + n] += modp(p, 1, m / NL, 2)[n] * v; }, g, gs);
}
DEVNI void ph_final(const Params& p, size_t g, size_t gs) {
    for (size_t it = g; it < (size_t)TL; it += gs) {
        float* h = p.out + it * D; float ss = 0.f; for (int k = 0; k < D; ++k) ss += h[k] * h[k];
        const float rstd = rsqrtf(ss / D + EPS); for (int k = 0; k < D; ++k) h[k] = h[k] * rstd * p.final_g[k];
    }
}

enum { PH_INIT, PH_MOD, PH_NORM, PH_EVIN, PH_FEATA, PH_FEATB, PH_BONUS, PH_RETSCAN, PH_RWKVSCAN, PH_MIXOUT, PH_WOUT, PH_MOEH, PH_MOEO,
       PH_MLAIN, PH_MLANORM, PH_UQ, PH_QROPE, PH_UKV, PH_SCORES, PH_SOFTMAX, PH_PV, PH_WO, PH_FINAL };
template <int PH> DEVFN void run_phase(const Params& p, int a0, int a1, int a2, size_t g, size_t gs) {
    if constexpr (PH == PH_INIT) ph_init(p, g, gs);
    else if constexpr (PH == PH_MOD) ph_mod(p, g, gs);
    else if constexpr (PH == PH_NORM) ph_norm(p, a0, a1, a2, g, gs);
    else if constexpr (PH == PH_EVIN) ph_gemm_evin(p, g, gs);
    else if constexpr (PH == PH_FEATA) ph_feat_a(p, g, gs);
    else if constexpr (PH == PH_FEATB) ph_feat_b(p, g, gs);
    else if constexpr (PH == PH_BONUS) ph_bonus(p, g, gs);
    else if constexpr (PH == PH_RETSCAN) ph_ret_scan(p, a0, g, gs);
    else if constexpr (PH == PH_RWKVSCAN) ph_rwkv_scan(p, a0, g, gs);
    else if constexpr (PH == PH_MIXOUT) ph_mixout(p, g, gs);
    else if constexpr (PH == PH_WOUT) ph_gemm_res(p, p.mix, p.ev_w_out, 0, 0, g, gs);
    else if constexpr (PH == PH_MOEH) ph_moe_hidden(p, a0, a1, g, gs);
    else if constexpr (PH == PH_MOEO) ph_moe_out(p, a0, a1, g, gs);
    else if constexpr (PH == PH_MLAIN) ph_gemm_mlain(p, g, gs);
    else if constexpr (PH == PH_MLANORM) ph_mla_norm(p, g, gs);
    else if constexpr (PH == PH_UQ) ph_gemm_uq(p, g, gs);
    else if constexpr (PH == PH_QROPE) ph_qrope(p, g, gs);
    else if constexpr (PH == PH_UKV) ph_gemm_ukv(p, g, gs);
    else if constexpr (PH == PH_SCORES) ph_scores(p, a0, g, gs);
    else if constexpr (PH == PH_SOFTMAX) ph_softmax(p, g, gs);
    else if constexpr (PH == PH_PV) ph_pv(p, a0, g, gs);
    else if constexpr (PH == PH_WO) ph_gemm_wo(p, g, gs);
    else if constexpr (PH == PH_FINAL) ph_final(p, g, gs);
}
#ifndef HOST_EMU
template <int PH> __global__ void __launch_bounds__(256) k_phase(Params p, int a0, int a1, int a2) {
    run_phase<PH>(p, a0, a1, a2, (size_t)blockIdx.x * blockDim.x + threadIdx.x, (size_t)gridDim.x * blockDim.x);
}
#define RUN(PH, a0, a1, a2) hipLaunchKernelGGL(k_phase<PH>, dim3(2048), dim3(256), 0, stream, p, a0, a1, a2)
#else
void emu_checkpoint(const char* name, const Params& p);
#define EMU_V 64
#define RUN(PH, a0, a1, a2) do { _Pragma("omp parallel for schedule(static,1)") for (int v_ = 0; v_ < EMU_V; ++v_) run_phase<PH>(p, a0, a1, a2, (size_t)v_, (size_t)EMU_V); } while (0)
#endif

struct WsLayout { size_t mod, eidx, ew, bonus, hctx, A, pret, prwlin, F, gate, qkva, cq, ckv, qraw, sc, kpe, qb, kvb, ao, total; };
static inline size_t al256(size_t x) { return (x + 255) & ~(size_t)255; }
static WsLayout make_layout() {
    WsLayout w; size_t o = 4096;
    w.mod = o; o = al256(o + (size_t)2 * (NB + 1) * NMOD * 4);
    w.eidx = o; o = al256(o + (size_t)T * 2 * 4);
    w.ew = o; o = al256(o + (size_t)T * 2 * 4);
    w.bonus = o; o = al256(o + (size_t)T * 8 * 4);
    w.hctx = o; o = al256(o + (size_t)TC * D * 4);
    w.A = o; o = al256(o + (size_t)T * D * 2);
    const size_t pool = o;
    w.pret = o; o = al256(o + (size_t)T * NRET * 2);
    w.prwlin = o; o = al256(o + (size_t)T * (SHIFT_W + NLIN) * 2);
    w.F = o; o = al256(o + (size_t)7 * T * 512 * 2);
    w.gate = o; o = al256(o + (size_t)T * 512 * 2);
    const size_t end0 = o;
    const size_t szA = al256((size_t)T * D * 2);
    w.sc = w.A; w.qraw = w.A;
    w.qkva = w.A + szA;
    size_t q = al256(w.qkva + (size_t)T * 704 * 4); { const size_t e = al256(w.qraw + (size_t)TL * 1536 * 4); if (e > q) q = e; }
    w.cq = q; q = al256(q + (size_t)T * 384 * 2);
    w.ckv = q; q = al256(q + (size_t)T * 256 * 2);
    { const size_t e = al256(w.sc + (size_t)8 * NL * SQ * 4); if (e > q) q = e; }
    w.kpe = q; q = al256(q + (size_t)T * 64 * 2);
    w.qb = q; q = al256(q + (size_t)TL * 1536 * 2);
    w.kvb = q; q = al256(q + (size_t)T * 2048 * 2);
    w.ao = q; q = al256(q + (size_t)TL * D * 2);
    w.total = end0 > q ? end0 : q; (void)pool;
    return w;
}

extern "C" void kernel_launch(void* const* d_in, const int* in_sizes, int n_in, void* d_out, int out_size, void* d_ws, size_t ws_size, hipStream_t stream) {
    (void)in_sizes; (void)n_in; (void)out_size;
    const WsLayout w = make_layout();
    if (w.total > ws_size) { fprintf(stderr, "workspace too small: need %zu have %zu\n", w.total, ws_size); return; }
    Params p{};
    const float* const* in = (const float* const*)d_in;
    p.x = in[0]; p.c = in[1]; p.ctx = in[2]; p.c_ctx = in[3]; p.ada_w = in[4]; p.ada_b = in[5]; p.norm1_g = in[6]; p.norm2_g = in[7]; p.final_g = in[8];
    p.ev_w_in = in[9]; p.ev_shift_mu = in[10]; p.rwkv_w0 = in[11]; p.rwkv_w2 = in[12]; p.rwkv_a0 = in[13]; p.rwkv_a2 = in[14]; p.rwkv_g2 = in[15];
    p.rwkv_k_k = in[16]; p.rwkv_k_a = in[17]; p.rwkv_r_k = in[18]; p.rwkv_lnx_w = in[19]; p.rwkv_lnx_b = in[20]; p.ev_w_out = in[21];
    p.mla_w_in = in[22]; p.mla_q_norm_g = in[23]; p.mla_w_uq = in[24]; p.mla_kv_norm_g = in[25]; p.mla_w_ukv = in[26]; p.mla_w_o = in[27];
    p.moe_w_grp = in[28]; p.moe_b_grp = in[29]; p.moe_w_exp = in[30]; p.moe_b_exp = in[31]; p.moe_w_gate = in[32]; p.moe_w_up = in[33]; p.moe_w_down = in[34];
    p.out = (float*)d_out;
    char* ws = (char*)d_ws;
    p.mod = (float*)(ws + w.mod); p.eidx = (int*)(ws + w.eidx); p.ew = (float*)(ws + w.ew); p.bonus = (float*)(ws + w.bonus); p.hctx = (float*)(ws + w.hctx);
    p.xn = (bf16_t*)(ws + w.A); p.fr = p.xn; p.fkk = p.xn + (size_t)T * 512; p.mix = p.xn;
    p.pret = (bf16_t*)(ws + w.pret); p.prw = (bf16_t*)(ws + w.prwlin); p.lin = p.prw + (size_t)T * SHIFT_W;
    p.ro = (float*)(ws + w.prwlin); p.yb = p.ro + (size_t)T * 512;
    bf16_t* F = (bf16_t*)(ws + w.F); const size_t fs = (size_t)T * 512;
    p.fv = F; p.fomw0 = F + fs; p.fomw1 = F + 2 * fs; p.fkka0 = F + 3 * fs; p.fkka1 = F + 4 * fs; p.fkt0 = F + 5 * fs; p.fkt1 = F + 6 * fs; p.fgate = (bf16_t*)(ws + w.gate);
    p.hid = p.pret;
    p.qkva = (float*)(ws + w.qkva); p.cq = (bf16_t*)(ws + w.cq); p.ckv = (bf16_t*)(ws + w.ckv); p.kpe = (bf16_t*)(ws + w.kpe); p.qraw = (float*)(ws + w.qraw);
    p.qb = (bf16_t*)(ws + w.qb); p.kvb = (bf16_t*)(ws + w.kvb); p.sc = (float*)(ws + w.sc); p.ao = (bf16_t*)(ws + w.ao);

    RUN(PH_INIT, 0, 0, 0);
    RUN(PH_MOD, 0, 0, 0);
    RUN(PH_NORM, 0, 1, 0);
    RUN(PH_EVIN, 0, 0, 0);
    RUN(PH_FEATA, 0, 0, 0);
    RUN(PH_FEATB, 0, 0, 0);
    RUN(PH_BONUS, 0, 0, 0);
    RUN(PH_RETSCAN, 0, 0, 0);
    RUN(PH_RETSCAN, 1, 0, 0);
    RUN(PH_RWKVSCAN, 0, 0, 0);
    RUN(PH_RWKVSCAN, 1, 0, 0);
    RUN(PH_MIXOUT, 0, 0, 0);
    RUN(PH_WOUT, 0, 0, 0);
#ifdef HOST_EMU
    emu_checkpoint("mix0", p);
#endif
    RUN(PH_NORM, 0, 2, 0);
    RUN(PH_MOEH, 0, 0, 0);
    RUN(PH_MOEO, 0, 0, 0);
#ifdef HOST_EMU
    emu_checkpoint("moe0", p);
#endif
    RUN(PH_NORM, 1, 1, 0);
    RUN(PH_MLAIN, 0, 0, 0);
    RUN(PH_MLANORM, 0, 0, 0);
    RUN(PH_UQ, 0, 0, 0);
    RUN(PH_QROPE, 0, 0, 0);
    RUN(PH_UKV, 0, 0, 0);
    for (int b = 0; b < NB; ++b) { RUN(PH_SCORES, b, 0, 0); RUN(PH_SOFTMAX, 0, 0, 0); RUN(PH_PV, b, 0, 0); }
    RUN(PH_WO, 0, 0, 0);
#ifdef HOST_EMU
    emu_checkpoint("mix1", p);
#endif
    RUN(PH_NORM, 1, 2, TC);
    RUN(PH_MOEH, 1, TC, 0);
    RUN(PH_MOEO, 1, TC, 0);
#ifdef HOST_EMU
    emu_checkpoint("moe1", p);
#endif
    RUN(PH_FINAL, 0, 0, 0);
}
```

```cpp
#ifndef HOST_EMU
#include <hip/hip_runtime.h>
#include <hip/hip_cooperative_groups.h>
#include <cstdio>
namespace cg = cooperative_groups;
#define DEVFN __device__ __forceinline__
#define DEVNI __device__ __forceinline__
typedef short bf16x8 __attribute__((ext_vector_type(8)));
typedef short bf16x4 __attribute__((ext_vector_type(4)));
typedef float f32x4 __attribute__((ext_vector_type(4)));
typedef float f32x16 __attribute__((ext_vector_type(16)));
#define MFMA16(a, b, c) __builtin_amdgcn_mfma_f32_16x16x32_bf16(a, b, c, 0, 0, 0)
#define MFMA32(a, b, c) __builtin_amdgcn_mfma_f32_32x32x16_bf16(a, b, c, 0, 0, 0)
#define SHFL_XOR(v, m) __shfl_xor(v, m)
#define WAVE_ANY(c) (__builtin_amdgcn_ballot_w64(c) != 0ull)
#define WAVE_SYNC() { __builtin_amdgcn_fence(__ATOMIC_RELEASE, "wavefront"); __builtin_amdgcn_wave_barrier(); __builtin_amdgcn_fence(__ATOMIC_ACQUIRE, "wavefront"); }
#define SPIN_PAUSE() __builtin_amdgcn_s_sleep(1)
#define SETPRIO(n) __builtin_amdgcn_s_setprio(n)
#define LDS_ARRAY(name, bytes) __shared__ __attribute__((aligned(16))) unsigned char name[bytes]
__device__ __forceinline__ int tid_opaque() { int t = threadIdx.x; asm volatile("" : "+v"(t)); return t; }
#define TIDX tid_opaque()
#else
#define DEVFN inline
#define DEVNI
#define __global__
typedef void* hipStream_t;
static inline float rsqrtf(float x) { return 1.0f / sqrtf(x); }
#define MFMA16(a, b, c) emu_mfma16(a, b, c)
#define MFMA32(a, b, c) emu_mfma32(a, b, c)
#define SHFL_XOR(v, m) emu_shfl_xor(v, m)
#define WAVE_ANY(c) (emu_ballot(c) != 0ull)
#define WAVE_SYNC() emu_wave_barrier();
#define SPIN_PAUSE() emu_yield()
#define SETPRIO(n)
#define LDS_ARRAY(name, bytes) static thread_local __attribute__((aligned(16))) unsigned char name[bytes]
#define TIDX ((int)threadIdx.x)
#endif
#include <cstddef>

#ifndef NB
#define NB 8
#endif
#ifndef NL
#define NL 2048
#endif
#ifndef NC
#define NC 256
#endif

typedef unsigned short bf16_t;

constexpr int D = 1024;
constexpr int SQ = NC + NL;
constexpr int TC = NB * NC;
constexpr int TL = NB * NL;
constexpr int T = TC + TL;
constexpr int EVEN_IN = 3488, SHIFT_W = 1952, NRET = 1536, NLIN = 416, LIN_LD = 448;
constexpr int NMOD = 6 * D;
constexpr float EPS = 1e-6f, GN_EPS = 64e-5f;

DEVFN float bf2f(bf16_t v) { unsigned u = ((unsigned)v) << 16; float f; memcpy(&f, &u, 4); return f; }
#ifndef HOST_EMU
DEVFN bf16_t f2bf(float f) { return __builtin_bit_cast(bf16_t, (__bf16)f); }
#else
DEVFN bf16_t f2bf(float f) { unsigned u; memcpy(&u, &f, 4); u += 0x7FFFu + ((u >> 16) & 1u); return (bf16_t)(u >> 16); }
#endif
#ifndef HOST_EMU
#define FAST_EXP2(x) __builtin_amdgcn_exp2f(x)
#define FAST_RCP(x) __builtin_amdgcn_rcpf(x)
#else
#define FAST_EXP2(x) exp2f(x)
#define FAST_RCP(x) (1.0f / (x))
#endif
typedef float f32x2 __attribute__((ext_vector_type(2)));
DEVFN float fast_sigmoid(float x) { return FAST_RCP(1.0f + FAST_EXP2(-1.4426950408889634f * x)); }
DEVFN float fast_silu(float x) { return x * fast_sigmoid(x); }
DEVFN float sigmoidf_(float x) { return 1.0f / (1.0f + expf(-x)); }
DEVFN float siluf_(float x) { return x / (1.0f + expf(-x)); }

constexpr int EVIN_NP = 3584;
constexpr int RCH = 128, NCC = NC / RCH, NLC = NL / RCH, NCH = NCC + NLC;
struct WsLayout { size_t hb, wrt, ys, fnrm, mod, eidx, ew, bonus, mcnt,  wts, wmoe, A, prw, lin, yf, fv, fgate, fkka1, fkt0, fkt1, mixr, mixw, retS, mlist, hid, qkva, cq, ckv, kpe, qb, kn, vT, ao, total; };
constexpr size_t al256(size_t x) { return (x + 255) & ~(size_t)255; }
constexpr WsLayout make_layout() {
    WsLayout w{}; size_t o = 16384;
    w.mod = o; o = al256(o + (size_t)2 * (NB + 1) * NMOD * 4);
    w.eidx = o; o = al256(o + (size_t)T * 2 * 4);
    w.ew = o; o = al256(o + (size_t)T * 2 * 4);
    w.bonus = o; o = al256(o + (size_t)T * 8 * 4);
    w.fnrm = o; o = al256(o + (size_t)T * 8 * 4);
    w.mcnt = o; o = al256(o + 64 * 4 + 1024 * 8);
    w.wts = o; o = al256(o + (size_t)(EVIN_NP * D + D * D + 768 * D + 1536 * 384 + 2048 * 256 + D * D + 2 * 512 * 64 + 2 * 512 * 64 + 512 * 192) * 2);
    w.wrt = o; o = al256(o + (size_t)4 * 48 * D * 2);
    w.wmoe = o; o = al256(o + (size_t)32 * (512 * D + D * 256) * 2);
    w.A = o; o = al256(o + (size_t)T * D * 2);
    const size_t pool = o; const size_t fs = al256((size_t)T * 512 * 2);
    w.prw = o; o = al256(o + (size_t)T * SHIFT_W * 2);
    w.lin = o; o = al256(o + (size_t)T * LIN_LD * 2);
    w.yf = w.prw;
    if ((size_t)2 * T * 512 * 4 > o - w.prw) o = al256(w.prw + (size_t)2 * T * 512 * 4);
    w.fv = o; o += fs; w.fgate = o; o += fs; w.fkka1 = o; o += fs; w.fkt0 = o; o += fs; w.fkt1 = o; o += fs;
    w.mixr = o; o += fs; w.mixw = o; o += fs;
    w.retS = o; o = al256(o + (size_t)NB * 4 * 2 * NCH * 8192 * 2);
    const size_t end0 = o;
    w.hb = w.prw;
    w.mlist = w.mixr; w.hid = 0  ; w.ys = al256(w.hb + (size_t)T * D * 2);
    if (w.ys + (size_t)T * 2 * D * 2 > w.mixr) w.ys = ~(size_t)0;
    o = al256(w.hb + (size_t)T * D * 2);
    w.qkva = o; o = al256(o + (size_t)T * 704 * 2);
    w.cq = 0; w.ckv = 0; w.kpe = 0;
    w.qb = o; o = al256(o + (size_t)TL * 1536 * 2);
    w.kn = o; o = al256(o + (size_t)T * 1024 * 2);
    w.vT = o; o = al256(o + (size_t)T * 1024 * 2);
    w.ao = 0;
    w.total = end0 > o ? end0 : o;
    return w;
}

constexpr WsLayout WL = make_layout();
static_assert(WL.ys != ~(size_t)0, "ys overlaps mlist");
static_assert((size_t)T * 704 * 2 + (size_t)TL * D * 2 <= (size_t)TL * D * 4 && (size_t)T * 2 * 256 * 2 <= (size_t)TL * D * 4, "d_out scratch capacity");
static_assert(NB != 8 || NL != 2048 || NC != 256 || WL.total <= 358461472ull, "workspace budget");

struct Params {
    const float *x, *c, *ctx, *c_ctx, *ada_w, *ada_b, *norm1_g, *norm2_g, *final_g;
    const float *ev_w_in, *ev_shift_mu, *rwkv_w0, *rwkv_w2, *rwkv_a0, *rwkv_a2, *rwkv_g2, *rwkv_k_k, *rwkv_k_a, *rwkv_r_k, *rwkv_lnx_w, *rwkv_lnx_b, *ev_w_out;
    const float *mla_w_in, *mla_q_norm_g, *mla_w_uq, *mla_kv_norm_g, *mla_w_ukv, *mla_w_o;
    const float *moe_w_grp, *moe_b_grp, *moe_w_exp, *moe_b_exp, *moe_w_gate, *moe_w_up, *moe_w_down;
    float* out;
    char* ws;
#define WSF(type, name, off) DEVFN type* name() const { return (type*)(ws + (off)); }
    WSF(unsigned, bar, 0)
    WSF(float, mod, WL.mod) WSF(int, eidx, WL.eidx) WSF(float, ew, WL.ew) WSF(float, bonus, WL.bonus) WSF(float, fnrm, WL.fnrm)
    WSF(int, mcnt, WL.mcnt) WSF(float, ropetab, WL.mcnt + 256) WSF(bf16_t, hb, WL.hb)
    WSF(bf16_t, xn, WL.A) WSF(bf16_t, fr, WL.A) WSF(bf16_t, fkk, WL.A + (size_t)T * 512 * 2)
    WSF(bf16_t, prw, WL.prw) WSF(bf16_t, lin, WL.lin) WSF(bf16_t, yf, WL.yf) WSF(bf16_t, ybw, WL.yf + (size_t)T * 512 * 2)
    WSF(bf16_t, fv, WL.fv) WSF(bf16_t, fgate, WL.fgate) WSF(bf16_t, fkka1, WL.fkka1) WSF(bf16_t, fkt0, WL.fkt0) WSF(bf16_t, fkt1, WL.fkt1)
    WSF(bf16_t, mixr, WL.mixr) WSF(bf16_t, mixw, WL.mixw) WSF(bf16_t, retS, WL.retS) WSF(int, mlist, WL.mlist) WSF(bf16_t, ys, WL.ys)
    WSF(bf16_t, qkva, WL.qkva) WSF(bf16_t, qb, WL.qb) WSF(bf16_t, kn, WL.kn) WSF(bf16_t, vT, WL.vT)
    WSF(bf16_t, wt_evin, WL.wts) WSF(bf16_t, wt_evout, WL.wts + (size_t)2 * EVIN_NP * D) WSF(bf16_t, wt_mlain, WL.wts + (size_t)2 * (EVIN_NP * D + D * D))
    WSF(bf16_t, wt_uq, WL.wts + (size_t)2 * (EVIN_NP * D + D * D + 768 * D)) WSF(bf16_t, wt_ukv, WL.wts + (size_t)2 * (EVIN_NP * D + D * D + 768 * D + 1536 * 384))
    WSF(bf16_t, wt_wo, WL.wts + (size_t)2 * (EVIN_NP * D + D * D + 768 * D + 1536 * 384 + 2048 * 256))
    WSF(bf16_t, wt_w2, WL.wts + (size_t)2 * (EVIN_NP * D + 2 * D * D + 768 * D + 1536 * 384 + 2048 * 256))
    WSF(bf16_t, wt_a2, WL.wts + (size_t)2 * (EVIN_NP * D + 2 * D * D + 768 * D + 1536 * 384 + 2048 * 256 + 2 * 512 * 64))
    WSF(bf16_t, wt_g2, WL.wts + (size_t)2 * (EVIN_NP * D + 2 * D * D + 768 * D + 1536 * 384 + 2048 * 256 + 4 * 512 * 64))
    WSF(bf16_t, wr_hi, WL.wrt) WSF(bf16_t, wr_lo, WL.wrt + (size_t)2 * 48 * D * 2)
    WSF(bf16_t, wt_gu, WL.wmoe) WSF(bf16_t, wt_dn, WL.wmoe + (size_t)2 * 32 * 512 * D)
#undef WSF
    DEVFN bf16_t* pret() const { return (bf16_t*)out; }
    DEVFN bf16_t* hid() const { return (bf16_t*)out; }
    DEVFN bf16_t* cq() const { return (bf16_t*)out; }
    DEVFN bf16_t* ckv() const { return (bf16_t*)out + (size_t)T * 384; }
    DEVFN bf16_t* kpe() const { return (bf16_t*)out + (size_t)T * 640; }
    DEVFN bf16_t* ao() const { return (bf16_t*)out + (size_t)T * 704; }
    DEVFN bf16_t* fomw0() const { return (bf16_t*)out; }
    DEVFN bf16_t* fomw1() const { return (bf16_t*)out + (size_t)T * 512; }
    DEVFN bf16_t* fkka0() const { return (bf16_t*)out + (size_t)2 * T * 512; }
};

DEVFN bf16_t* hrow(const Params& p, int tk) { return p.hb() + (size_t)tk * D; }
DEVFN const float* hin(const Params& p, int tk) { return tk < TC ? p.ctx + (size_t)tk * D : p.x + (size_t)(tk - TC) * D; }
DEVFN int modrow(int tk) { return tk < TC ? NB : (tk - TC) / NL; }
DEVFN const float* modp(const Params& p, int layer, int mr, int which) { return p.mod() + (((size_t)layer * (NB + 1) + mr) * 6 + which) * D; }
DEVFN int scan_tok(int b, int dir, int step) {
    if (step < NC) return b * NC + (dir ? NC - 1 - step : step);
    const int t = step - NC; return TC + b * NL + (dir ? NL - 1 - t : t);
}
DEVFN int key_tok(int b, int key) { return key < NC ? b * NC + key : TC + b * NL + (key - NC); }

typedef unsigned u32x4 __attribute__((ext_vector_type(4)));
typedef unsigned u32x2 __attribute__((ext_vector_type(2)));
constexpr int GBM = 128, GBN = 128, GBK = 64;
constexpr int G_STAGE = (GBM + GBN) * GBK * 2;
constexpr int LDS_BYTES = 2 * G_STAGE;
#ifndef HOST_EMU
typedef __bf16 bf16n2 __attribute__((ext_vector_type(2)));
typedef float f32n2 __attribute__((ext_vector_type(2)));
DEVFN unsigned pack2bf(float a, float b) { const f32n2 v = {a, b}; return __builtin_bit_cast(unsigned, __builtin_convertvector(v, bf16n2)); }
#else
DEVFN unsigned pack2bf(float a, float b) { return (unsigned)f2bf(a) | ((unsigned)f2bf(b) << 16); }
#endif
DEVFN u32x2 pack4bf(f32x4 v) { u32x2 r; r.x = pack2bf(v[0], v[1]); r.y = pack2bf(v[2], v[3]); return r; }
DEVFN f32x4 ld4bf(const bf16_t* q) { const u32x2 w = *(const u32x2*)q; f32x4 r; r[0] = __builtin_bit_cast(float, w.x << 16); r[1] = __builtin_bit_cast(float, w.x & 0xffff0000u); r[2] = __builtin_bit_cast(float, w.y << 16); r[3] = __builtin_bit_cast(float, w.y & 0xffff0000u); return r; }

struct GemmSrcA {
    const bf16_t* base; int ld;
    const bf16_t* base2; int ld2; int ksplit;
    const int* rowidx; int nvalid; int rowshift;
};
DEVFN GemmSrcA plainA(const bf16_t* base, int ld) { GemmSrcA a; a.base = base; a.ld = ld; a.base2 = base; a.ld2 = ld; a.ksplit = 1 << 30; a.rowidx = nullptr; a.nvalid = 0; a.rowshift = 0; return a; }

template <bool TRANS, class Epi>
DEVFN void gemm_tile(unsigned char* lds, const GemmSrcA& A, int m0, const bf16_t* Bt, int ldb, int n0, int K, Epi epi) {
    const int tid = TIDX, lane = tid & 63, wave = tid >> 6, wm = wave >> 1, wn = wave & 1, fr = lane & 15, fq = lane >> 4;
    const int lr = tid >> 3, kc = tid & 7;
    const bf16_t* pA[4]; const bf16_t* pA2[4]; const bf16_t* pB[4]; int soff[4];
#pragma unroll
    for (int i = 0; i < 4; ++i) {
        const int r = lr + 32 * i; int gr = m0 + r;
        if (A.rowidx) { const int q = gr < A.nvalid ? gr : A.nvalid - 1; gr = A.rowidx[q] >> A.rowshift; }
        pA[i] = A.base + (size_t)gr * A.ld + kc * 8; pA2[i] = A.base2 + (size_t)gr * A.ld2 + kc * 8 - A.ksplit;
        pB[i] = Bt + (size_t)(n0 + r) * ldb + kc * 8;
        soff[i] = r * 128 + ((kc ^ ((r >> 1) & 7)) << 4);
    }
    f32x4 acc[4][4];
#pragma unroll
    for (int mi = 0; mi < 4; ++mi)
#pragma unroll
        for (int ni = 0; ni < 4; ++ni) acc[mi][ni] = (f32x4){0.f, 0.f, 0.f, 0.f};
    u32x4 ra[4], rb[4], ra2[4], rb2[4];
    const int nk = K / GBK;
#define G_GLOADX(kt, RA, RB) { const int k0_ = (kt) * GBK; _Pragma("unroll") for (int i = 0; i < 4; ++i) { RA[i] = *(const u32x4*)((k0_ < A.ksplit ? pA[i] : pA2[i]) + k0_); RB[i] = *(const u32x4*)(pB[i] + k0_); } }
#define G_LSTOREX(st, RA, RB) { unsigned char* sb_ = lds + (st) * G_STAGE; _Pragma("unroll") for (int i = 0; i < 4; ++i) { *(u32x4*)(sb_ + soff[i]) = RA[i]; *(u32x4*)(sb_ + 16384 + soff[i]) = RB[i]; } }
#define G_COMPUTE(kt) { const unsigned char* sa = lds + ((kt) & 1) * G_STAGE; const unsigned char* sb = sa + 16384; \
        _Pragma("unroll") for (int ks = 0; ks < 2; ++ks) { bf16x8 af[4], bfr[4]; const int ch = ks * 4 + fq; \
            _Pragma("unroll") for (int i = 0; i < 4; ++i) { const int ra_ = wm * 64 + i * 16 + fr, rb_ = wn * 64 + i * 16 + fr; \
                af[i] = *(const bf16x8*)(sa + ra_ * 128 + ((ch ^ ((ra_ >> 1) & 7)) << 4)); bfr[i] = *(const bf16x8*)(sb + rb_ * 128 + ((ch ^ ((rb_ >> 1) & 7)) << 4)); } \
            SETPRIO(1); _Pragma("unroll") for (int mi = 0; mi < 4; ++mi) _Pragma("unroll") for (int ni = 0; ni < 4; ++ni) acc[mi][ni] = TRANS ? MFMA16(bfr[ni], af[mi], acc[mi][ni]) : MFMA16(af[mi], bfr[ni], acc[mi][ni]); SETPRIO(0); } }
    G_GLOADX(0, ra, rb) G_LSTOREX(0, ra, rb)
    if (nk > 1) G_GLOADX(1, ra, rb)
    if (nk > 2) G_GLOADX(2, ra2, rb2)
    __syncthreads();
    for (int kt = 0; kt < nk; kt += 2) {
        if (kt + 1 < nk) { G_LSTOREX((kt + 1) & 1, ra, rb) if (kt + 3 < nk) G_GLOADX(kt + 3, ra, rb) }
        G_COMPUTE(kt)
        __syncthreads();
        if (kt + 1 < nk) {
            if (kt + 2 < nk) { G_LSTOREX((kt + 2) & 1, ra2, rb2) if (kt + 4 < nk) G_GLOADX(kt + 4, ra2, rb2) }
            G_COMPUTE(kt + 1)
            __syncthreads();
        }
    }
#undef G_GLOADX
#undef G_LSTOREX
#undef G_COMPUTE
#define G_GLOAD(x)
#define G_LSTORE(x)
#undef G_GLOAD
#undef G_LSTORE
    epi(acc, m0 + wm * 64, n0 + wn * 64, fr, fq);
}


constexpr int GBM2 = 256, GBK2 = 32, G2_STAGE = (GBM2 + GBN) * GBK2 * 2;
static_assert(2 * G2_STAGE <= LDS_BYTES, "gemm2 LDS");
template <bool TRANS, class Epi>
DEVFN void gemm_tile2(unsigned char* lds, const GemmSrcA& A, int m0, const bf16_t* Bt, int ldb, int n0, int K, Epi epi) {
    const int tid = TIDX, lane = tid & 63, wave = tid >> 6, wm = wave >> 1, wn = wave & 1, fr = lane & 15, fq = lane >> 4;
    const int lr = tid >> 2, kc = tid & 3;
    const bf16_t* pA[4]; const bf16_t* pB[2]; int sA[4], sB[2];
#pragma unroll
    for (int i = 0; i < 4; ++i) { const int r = lr + 64 * i; pA[i] = A.base + (size_t)(m0 + r) * A.ld + kc * 8; sA[i] = r * 64 + ((kc ^ ((r >> 2) & 3)) << 4); }
#pragma unroll
    for (int i = 0; i < 2; ++i) { const int r = lr + 64 * i; pB[i] = Bt + (size_t)(n0 + r) * ldb + kc * 8; sB[i] = GBM2 * 64 + r * 64 + ((kc ^ ((r >> 2) & 3)) << 4); }
    f32x4 acc[2][4][4];
#pragma unroll
    for (int hf = 0; hf < 2; ++hf)
#pragma unroll
        for (int mi = 0; mi < 4; ++mi)
#pragma unroll
            for (int ni = 0; ni < 4; ++ni) acc[hf][mi][ni] = (f32x4){0.f, 0.f, 0.f, 0.f};
    u32x4 ra[4], rb[2];
    const int nk = K / GBK2;
#define G2_GLOAD(kt) { const int k0_ = (kt) * GBK2; _Pragma("unroll") for (int i = 0; i < 4; ++i) ra[i] = *(const u32x4*)(pA[i] + k0_); _Pragma("unroll") for (int i = 0; i < 2; ++i) rb[i] = *(const u32x4*)(pB[i] + k0_); }
#define G2_LSTORE(st) { unsigned char* sb_ = lds + (st) * G2_STAGE; _Pragma("unroll") for (int i = 0; i < 4; ++i) *(u32x4*)(sb_ + sA[i]) = ra[i]; _Pragma("unroll") for (int i = 0; i < 2; ++i) *(u32x4*)(sb_ + sB[i]) = rb[i]; }
    G2_GLOAD(0) G2_LSTORE(0)
    if (nk > 1) G2_GLOAD(1)
    __syncthreads();
    for (int kt = 0; kt < nk; ++kt) {
        if (kt + 1 < nk) { G2_LSTORE((kt + 1) & 1) if (kt + 2 < nk) G2_GLOAD(kt + 2) }
        const unsigned char* sa = lds + (kt & 1) * G2_STAGE; const unsigned char* sb = sa + GBM2 * 64;
        bf16x8 bfr[4];
#pragma unroll
        for (int i = 0; i < 4; ++i) { const int r = wn * 64 + i * 16 + fr; bfr[i] = *(const bf16x8*)(sb + r * 64 + ((fq ^ ((r >> 2) & 3)) << 4)); }
        SETPRIO(1);
#pragma unroll
        for (int hf = 0; hf < 2; ++hf)
#pragma unroll
            for (int mi = 0; mi < 4; ++mi) { const int r = wm * 128 + hf * 64 + mi * 16 + fr; const bf16x8 af = *(const bf16x8*)(sa + r * 64 + ((fq ^ ((r >> 2) & 3)) << 4));
#pragma unroll
                for (int ni = 0; ni < 4; ++ni) acc[hf][mi][ni] = TRANS ? MFMA16(bfr[ni], af, acc[hf][mi][ni]) : MFMA16(af, bfr[ni], acc[hf][mi][ni]); }
        SETPRIO(0);
        __syncthreads();
    }
#undef G2_GLOAD
#undef G2_LSTORE
    epi(acc[0], m0 + wm * 128, n0 + wn * 64, fr, fq);
    epi(acc[1], m0 + wm * 128 + 64, n0 + wn * 64, fr, fq);
}

struct ConvJob { const float* src; int ldsrc, K, N; bf16_t* dst; int Kpad, Npad, mode; };
DEVFN int conv_tiles(const ConvJob& j) { return (j.Npad / 64) * (j.Kpad / 64); }
DEVFN void conv_tile(unsigned char* lds, const ConvJob& j, int tile) {
    float* t = (float*)lds; const int tid = TIDX; const int ntn = j.Npad / 64, tn = tile % ntn, tk = tile / ntn;
    { const int r = tid >> 4, c4 = (tid & 15) * 4;
#pragma unroll
      for (int i = 0; i < 4; ++i) { const int k = tk * 64 + r + 16 * i, n = tn * 64 + c4; f32x4 v = (f32x4){0.f, 0.f, 0.f, 0.f};
          if (k < j.K && n < j.N) v = *(const f32x4*)(j.src + (size_t)k * j.ldsrc + n);
          float* d = t + (r + 16 * i) * 65 + c4; d[0] = v[0]; d[1] = v[1]; d[2] = v[2]; d[3] = v[3]; } }
    __syncthreads();
    { const int nl = tid >> 2, kq = (tid & 3) * 16; int row = tn * 64 + nl;
      if (j.mode) { const int c = row; row = (c >> 6) * 128 + ((c >> 5) & 1) * 64 + (c & 31) + (j.mode == 2 ? 32 : 0); }
      u32x4 o0, o1;
      o0.x = pack2bf(t[(kq + 0) * 65 + nl], t[(kq + 1) * 65 + nl]); o0.y = pack2bf(t[(kq + 2) * 65 + nl], t[(kq + 3) * 65 + nl]);
      o0.z = pack2bf(t[(kq + 4) * 65 + nl], t[(kq + 5) * 65 + nl]); o0.w = pack2bf(t[(kq + 6) * 65 + nl], t[(kq + 7) * 65 + nl]);
      o1.x = pack2bf(t[(kq + 8) * 65 + nl], t[(kq + 9) * 65 + nl]); o1.y = pack2bf(t[(kq + 10) * 65 + nl], t[(kq + 11) * 65 + nl]);
      o1.z = pack2bf(t[(kq + 12) * 65 + nl], t[(kq + 13) * 65 + nl]); o1.w = pack2bf(t[(kq + 14) * 65 + nl], t[(kq + 15) * 65 + nl]);
      bf16_t* d = j.dst + (size_t)row * j.Kpad + tk * 64 + kq; *(u32x4*)d = o0; *(u32x4*)(d + 8) = o1; }
    __syncthreads();
}
DEVFN ConvJob mkjob(const float* src, int ldsrc, int K, int N, bf16_t* dst, int Kpad, int Npad, int mode) { ConvJob j; j.src = src; j.ldsrc = ldsrc; j.K = K; j.N = N; j.dst = dst; j.Kpad = Kpad; j.Npad = Npad; j.mode = mode; return j; }
static_assert((size_t)T * NRET * 2 <= (size_t)TL * D * 4, "pret must fit in d_out");
DEVNI void bk_convert_dense(const Params& p, unsigned char* lds, int which = 2  , int b0 = 0) {
    __syncthreads();
    if ((int)blockIdx.x < b0) return;
    ConvJob jobs[11];
    jobs[0] = mkjob(p.ev_w_in, EVEN_IN, D, EVEN_IN, p.wt_evin(), D, EVIN_NP, 0);
    jobs[1] = mkjob(p.ev_w_out, D, D, D, p.wt_evout(), D, D, 0);
    jobs[2] = mkjob(p.mla_w_in, 704, D, 704, p.wt_mlain(), D, 768, 0);
    jobs[3] = mkjob(p.mla_w_uq, 1536, 384, 1536, p.wt_uq(), 384, 1536, 0);
    jobs[4] = mkjob(p.mla_w_ukv, 2048, 256, 2048, p.wt_ukv(), 256, 2048, 0);
    jobs[5] = mkjob(p.mla_w_o, D, D, D, p.wt_wo(), D, D, 0);
    jobs[6] = mkjob(p.rwkv_w2, 512, 64, 512, p.wt_w2(), 64, 512, 0);
    jobs[7] = mkjob(p.rwkv_w2 + 64 * 512, 512, 64, 512, p.wt_w2() + 512 * 64, 64, 512, 0);
    jobs[8] = mkjob(p.rwkv_a2, 512, 64, 512, p.wt_a2(), 64, 512, 0);
    jobs[9] = mkjob(p.rwkv_a2 + 64 * 512, 512, 64, 512, p.wt_a2() + 512 * 64, 64, 512, 0);
    jobs[10] = mkjob(p.rwkv_g2, 512, 160, 512, p.wt_g2(), 192, 512, 0);
    int total = 0;
#pragma unroll
    for (int i = 0; i < 11; ++i) { const bool l1job = (i >= 2 && i <= 5); if (which == 2 || (which == 1) == l1job) total += conv_tiles(jobs[i]); }
    for (int it = (int)blockIdx.x - b0; it < total; it += gridDim.x - b0) {
        int t = it;
#pragma unroll
        for (int i = 0; i < 11; ++i) { const bool l1job = (i >= 2 && i <= 5); if (which == 2 || (which == 1) == l1job) { const int n = conv_tiles(jobs[i]); if (t >= 0 && t < n) conv_tile(lds, jobs[i], t); t -= n; } }
    }
}
DEVNI void bk_convert_moe(const Params& p, unsigned char* lds, int layer, int b0 = 0) {
    __syncthreads();
    if ((int)blockIdx.x < b0) return;
    for (int it = blockIdx.x - b0; it < 32 * 192; it += gridDim.x - b0) {
        const int e = it / 192, r = it % 192, kind = r / 64, t = r % 64; ConvJob j;
        if (kind == 0) j = mkjob(p.moe_w_gate + (size_t)(layer * 32 + e) * D * 256, 256, D, 256, p.wt_gu() + (size_t)e * 512 * D, D, 256, 1);
        else if (kind == 1) j = mkjob(p.moe_w_up + (size_t)(layer * 32 + e) * D * 256, 256, D, 256, p.wt_gu() + (size_t)e * 512 * D, D, 256, 2);
        else j = mkjob(p.moe_w_down + (size_t)(layer * 32 + e) * 256 * D, D, 256, D, p.wt_dn() + (size_t)e * D * 256, 256, D, 0);
        conv_tile(lds, j, t);
    }
}
DEVNI void bk_evin(const Params& p, unsigned char* lds) {
    const GemmSrcA A = plainA(p.xn(), D); constexpr int NTM = T / GBM2, NTN = EVIN_NP / GBN;
    for (int it = blockIdx.x; it < NTM * NTN; it += gridDim.x) {
        const int mt = it % NTM, nt = it / NTM;
        gemm_tile2<true>(lds, A, mt * GBM2, p.wt_evin(), D, nt * GBN, D, [&](f32x4 (&acc)[4][4], int mb, int nb, int fr, int fq) {
#pragma unroll
            for (int mi = 0; mi < 4; ++mi)
#pragma unroll
                for (int ni = 0; ni < 4; ++ni) { const int row = mb + mi * 16 + fr, col = nb + ni * 16 + fq * 4; f32x4 v = acc[mi][ni];
                    if (col < NRET) { if (col < 256) v = v * 0.125f; *(u32x2*)(p.pret() + (size_t)row * NRET + col) = pack4bf(v); }
                    else if (col < EVEN_IN) *(u32x2*)(p.prw() + (size_t)row * SHIFT_W + (col - NRET)) = pack4bf(v); }
        });
    }
}


template <bool BIG>
DEVNI void bk_res_gemm(const Params& p, unsigned char* lds, const GemmSrcA& A, const bf16_t* Wt, int K, int layer, int row0  , int nrows, bool first) {
    const int ntm = nrows / (BIG ? GBM2 : GBM);
    for (int it = blockIdx.x; it < ntm * 8; it += gridDim.x) {
        const int mt = it % ntm, nt = it / ntm;
        auto epi = [&](f32x4 (&acc)[4][4], int mb, int nb, int fr, int fq) {
#pragma unroll
            for (int mi = 0; mi < 4; ++mi) { const int tk = row0 + mb + mi * 16 + fr; bf16_t* hr = hrow(p, tk); const float* src = hin(p, tk); const float* m2 = modp(p, layer, modrow(tk), 2);
#pragma unroll
                for (int ni = 0; ni < 4; ++ni) { const int col = nb + ni * 16 + fq * 4; const f32x4 sv = first ? *(const f32x4*)(src + col) : ld4bf(hr + col);
                    *(u32x2*)(hr + col) = pack4bf(sv + *(const f32x4*)(m2 + col) * acc[mi][ni]); } }
        };
        if (BIG) gemm_tile2<true>(lds, A, mt * GBM2, Wt, K, nt * GBN, K, epi); else gemm_tile<true>(lds, A, mt * GBM, Wt, K, nt * GBN, K, epi);
    }
}
DEVNI void bk_wout(const Params& p, unsigned char* lds) { GemmSrcA A = plainA(p.mixr(), 512); A.base2 = p.mixw(); A.ld2 = 512; A.ksplit = 512; bk_res_gemm<false>(p, lds, A, p.wt_evout(), D, 0, 0, T, true); }
DEVNI void bk_wo(const Params& p, unsigned char* lds) { bk_res_gemm<true>(p, lds, plainA(p.ao(), D), p.wt_wo(), D, 1, TC, TL, false); }
DEVNI void bk_mlain(const Params& p, unsigned char* lds) {
    const GemmSrcA A = plainA(p.xn(), D); constexpr int NTM = T / GBM2, NTN = 768 / GBN;
    for (int it = blockIdx.x; it < NTM * NTN; it += gridDim.x) {
        const int mt = it % NTM, nt = it / NTM;
        gemm_tile2<true>(lds, A, mt * GBM2, p.wt_mlain(), D, nt * GBN, D, [&](f32x4 (&acc)[4][4], int mb, int nb, int fr, int fq) {
#pragma unroll
            for (int mi = 0; mi < 4; ++mi)
#pragma unroll
                for (int ni = 0; ni < 4; ++ni) { const int row = mb + mi * 16 + fr, col = nb + ni * 16 + fq * 4; if (col < 704) *(u32x2*)(p.qkva() + (size_t)row * 704 + col) = pack4bf(acc[mi][ni]); }
        });
    }
}
constexpr int LCAP = T * 2;
DEVFN bool moe_item(const int* cnt, int it, int ntn, int& e, int& mt, int& nt) {
    int t = it;
    for (int i = 0; i < 32; ++i) { const int n = ((cnt[i] + GBM - 1) / GBM) * ntn; if (t < n) { e = i; mt = t / ntn; nt = t % ntn; return true; } t -= n; }
    return false;
}
DEVNI void bk_moe_hidden(const Params& p, unsigned char* lds, int layer) {
    const int* cnt = p.mcnt() + layer * 32;
    for (int it = blockIdx.x;; it += gridDim.x) {
        int e, mt, nt; if (!moe_item(cnt, it, 4, e, mt, nt)) break;
        const int* lst = p.mlist() + (size_t)e * LCAP; const int nv = cnt[e];
        GemmSrcA A = plainA(p.xn(), D); A.rowidx = lst; A.nvalid = nv; A.rowshift = 1;
        gemm_tile<true>(lds, A, mt * GBM, p.wt_gu() + (size_t)e * 512 * D, D, nt * GBN, D, [&](f32x4 (&acc)[4][4], int mb, int nb, int fr, int fq) {
            const int wn = (nb / 64) & 1;
#pragma unroll
            for (int mi = 0; mi < 4; ++mi) { const int li = mb + mi * 16 + fr; if (li < nv) { const int pair = lst[li];
#pragma unroll
                for (int ni = 0; ni < 2; ++ni) { const f32x4 g = acc[mi][ni], u = acc[mi][ni + 2]; f32x4 hv;
#pragma unroll
                    for (int r = 0; r < 4; ++r) hv[r] = fast_silu(g[r]) * u[r];
                    *(u32x2*)(p.hid() + (size_t)pair * 256 + nt * 64 + wn * 32 + ni * 16 + fq * 4) = pack4bf(hv); } } }
        });
    }
}
DEVNI void bk_moe_down(const Params& p, unsigned char* lds, int layer) {
    const int* cnt = p.mcnt() + layer * 32;
    for (int it = blockIdx.x;; it += gridDim.x) {
        int e, mt, nt; if (!moe_item(cnt, it, 8, e, mt, nt)) break;
        const int* lst = p.mlist() + (size_t)e * LCAP; const int nv = cnt[e];
        GemmSrcA A = plainA(p.hid(), 256); A.rowidx = lst; A.nvalid = nv; A.rowshift = 0;
        gemm_tile<true>(lds, A, mt * GBM, p.wt_dn() + (size_t)e * D * 256, 256, nt * GBN, 256, [&](f32x4 (&acc)[4][4], int mb, int nb, int fr, int fq) {
#pragma unroll
            for (int mi = 0; mi < 4; ++mi) { const int li = mb + mi * 16 + fr; if (li < nv) { const int pair = lst[li], tk = pair >> 1; const float w = p.ew()[pair];
                const float* m5 = modp(p, layer, modrow(tk), 5); bf16_t* yr = p.ys() + (size_t)pair * D;
#pragma unroll
                for (int ni = 0; ni < 4; ++ni) { const int col = nb + ni * 16 + fq * 4; *(u32x2*)(yr + col) = pack4bf(*(const f32x4*)(m5 + col) * acc[mi][ni] * w); } } }
        });
    }
}


constexpr float QSCALE = 0.07216878364870322f * 1.4426950408889634f;
DEVNI void bk_uq_rope(const Params& p, unsigned char* lds) {
    const GemmSrcA A = plainA(p.cq() + (size_t)TC * 384, 384); constexpr int NTM = TL / GBM2, NTN = 1536 / GBN;
    for (int it = blockIdx.x; it < NTM * NTN; it += gridDim.x) {
        const int mt = it % NTM, nt = it / NTM;
        gemm_tile2<true>(lds, A, mt * GBM2, p.wt_uq(), 384, nt * GBN, 384, [&](f32x4 (&acc)[4][4], int mb, int nb, int fr, int fq) {
            const bool rope = ((nb / 64) % 3) == 2;
#pragma unroll
            for (int mi = 0; mi < 4; ++mi) { const int row = mb + mi * 16 + fr, t = row % NL;
                if (rope) {
#pragma unroll
                    for (int hf = 0; hf < 2; ++hf) { const int pos = hf ? (t % 64) : (t / 64);
#pragma unroll
                        for (int r = 0; r < 4; ++r) { const int i = fq * 4 + r; const float cs = p.ropetab()[(pos * 16 + i) * 2], sn = p.ropetab()[(pos * 16 + i) * 2 + 1];
                            const float t1 = acc[mi][2 * hf][r], t2 = acc[mi][2 * hf + 1][r]; acc[mi][2 * hf][r] = t1 * cs - t2 * sn; acc[mi][2 * hf + 1][r] = t2 * cs + t1 * sn; } } }
#pragma unroll
                for (int ni = 0; ni < 4; ++ni) { const int col = nb + ni * 16 + fq * 4; *(u32x2*)(p.qb() + (size_t)row * 1536 + col) = pack4bf(acc[mi][ni] * QSCALE); } }
        });
    }
}
DEVNI void bk_ukv_split(const Params& p, unsigned char* lds) {
    const GemmSrcA A = plainA(p.ckv(), 256); constexpr int NTM = T / GBM2, NTN = 2048 / GBN;
    for (int it = blockIdx.x; it < NTM * NTN; it += gridDim.x) {
        const int mt = it % NTM, nt = it / NTM, h = nt >> 1;
        if ((nt & 1) == 0) {
            gemm_tile2<true>(lds, A, mt * GBM2, p.wt_ukv(), 256, nt * GBN, 256, [&](f32x4 (&acc)[4][4], int mb, int nb, int fr, int fq) {
#pragma unroll
                for (int mi = 0; mi < 4; ++mi)
#pragma unroll
                    for (int ni = 0; ni < 4; ++ni) { const int row = mb + mi * 16 + fr, c = (nb & 127) + ni * 16 + fq * 4; *(u32x2*)(p.kn() + (size_t)row * 1024 + h * 128 + c) = pack4bf(acc[mi][ni]); }
            });
        } else {
            gemm_tile2<false>(lds, A, mt * GBM2, p.wt_ukv(), 256, nt * GBN, 256, [&](f32x4 (&acc)[4][4], int mb, int nb, int fr, int fq) {
#pragma unroll
                for (int mi = 0; mi < 4; ++mi) { const int tk = mb + mi * 16 + fq * 4; int b, key; if (tk < TC) { b = tk / NC; key = tk % NC; } else { b = (tk - TC) / NL; key = NC + (tk - TC) % NL; }
#pragma unroll
                    for (int ni = 0; ni < 4; ++ni) { const int d = (nb & 127) + ni * 16 + fr; *(u32x2*)(p.vT() + ((size_t)(b * 8 + h) * 128 + d) * SQ + key) = pack4bf(acc[mi][ni]); } }
            });
        }
    }
}
constexpr int FA_KROW = 400, FA_VROW = 72, FA_KBYTES = 32 * FA_KROW, FA_BUF = FA_KBYTES + 128 * FA_VROW;
static_assert(2 * FA_BUF <= LDS_BYTES, "attention LDS");
DEVNI void bk_attn(const Params& p, unsigned char* lds) {
    const int tid = TIDX, lane = tid & 63, wave = tid >> 6, lq = lane & 31, hh = lane >> 5;
    constexpr int NQT = NL / 128, NKT = SQ / 32;
    for (int it = blockIdx.x; it < NB * 8 * NQT; it += gridDim.x) {
        const int qt = it % NQT, h = (it / NQT) % 8, b = it / (NQT * 8);
        bf16x8 qf[12];
        { const bf16_t* qp = p.qb() + ((size_t)(b * NL + qt * 128 + wave * 32 + lq) * 8 + h) * 192 + 8 * hh;
#pragma unroll
          for (int ks = 0; ks < 12; ++ks) qf[ks] = *(const bf16x8*)(qp + ks * 16); }
        f32x16 oT[4];
#pragma unroll
        for (int dt = 0; dt < 4; ++dt)
#pragma unroll
            for (int r = 0; r < 16; ++r) oT[dt][r] = 0.f;
        float mrun = -1.0e30f, lrun = 0.f;
        u32x4 kreg[3], vreg[2];
        const bf16_t* vbase = p.vT() + (size_t)(b * 8 + h) * 128 * SQ;
#define FA_GLOAD(kt) { const int key0_ = (kt) * 32; \
            _Pragma("unroll") for (int i = 0; i < 3; ++i) { const int c_ = tid + i * 256, row_ = c_ / 24, ch_ = c_ % 24; const int tok_ = key_tok(b, key0_ + row_); \
                kreg[i] = ch_ < 16 ? *(const u32x4*)(p.kn() + (size_t)tok_ * 1024 + h * 128 + ch_ * 8) : *(const u32x4*)(p.kpe() + (size_t)tok_ * 64 + (ch_ - 16) * 8); } \
            _Pragma("unroll") for (int i = 0; i < 2; ++i) { const int c_ = tid + i * 256, d_ = c_ >> 2, kc_ = c_ & 3; vreg[i] = *(const u32x4*)(vbase + (size_t)d_ * SQ + key0_ + kc_ * 8); } }
#define FA_LSTORE(bf) { unsigned char* sb_ = lds + (bf) * FA_BUF; \
            _Pragma("unroll") for (int i = 0; i < 3; ++i) { const int c_ = tid + i * 256, row_ = c_ / 24, ch_ = c_ % 24; *(u32x4*)(sb_ + row_ * FA_KROW + ch_ * 16) = kreg[i]; } \
            _Pragma("unroll") for (int i = 0; i < 2; ++i) { const int c_ = tid + i * 256, d_ = c_ >> 2, kc_ = c_ & 3; u32x2 lo_, hi_; lo_.x = vreg[i].x; lo_.y = vreg[i].y; hi_.x = vreg[i].z; hi_.y = vreg[i].w; \
                *(u32x2*)(sb_ + FA_KBYTES + d_ * FA_VROW + kc_ * 16) = lo_; *(u32x2*)(sb_ + FA_KBYTES + d_ * FA_VROW + kc_ * 16 + 8) = hi_; } }
        __syncthreads();
        FA_GLOAD(0) FA_LSTORE(0)
        __syncthreads();
        for (int kt = 0; kt < NKT; ++kt) {
            if (kt + 1 < NKT) FA_GLOAD(kt + 1)
            const unsigned char* sk = lds + (kt & 1) * FA_BUF; const unsigned char* sv = sk + FA_KBYTES;
            f32x16 sT;
#pragma unroll
            for (int r = 0; r < 16; ++r) sT[r] = 0.f;
            SETPRIO(1);
#pragma unroll
            for (int ks = 0; ks < 12; ++ks) { const bf16x8 kf = *(const bf16x8*)(sk + lq * FA_KROW + (ks * 2 + hh) * 16); sT = MFMA32(kf, qf[ks], sT); }
            SETPRIO(0);
            float mx = sT[0];
#pragma unroll
            for (int r = 1; r < 16; ++r) mx = fmaxf(mx, sT[r]);
            mx = fmaxf(mx, SHFL_XOR(mx, 32));
            if (WAVE_ANY(mx > mrun + 8.0f)) {
                const float mnew = fmaxf(mrun, mx), alpha = FAST_EXP2(mrun - mnew); mrun = mnew; lrun *= alpha;
#pragma unroll
                for (int dt = 0; dt < 4; ++dt) oT[dt] = oT[dt] * alpha;
            }
            float ps = 0.f;
#pragma unroll
            for (int r = 0; r < 16; ++r) { const float e = FAST_EXP2(sT[r] - mrun); sT[r] = e; ps += e; }
            lrun += ps;
#pragma unroll
            for (int s2 = 0; s2 < 2; ++s2) {
                u32x4 pw; pw.x = pack2bf(sT[8 * s2], sT[8 * s2 + 1]); pw.y = pack2bf(sT[8 * s2 + 2], sT[8 * s2 + 3]); pw.z = pack2bf(sT[8 * s2 + 4], sT[8 * s2 + 5]); pw.w = pack2bf(sT[8 * s2 + 6], sT[8 * s2 + 7]);
                const bf16x8 pf = __builtin_bit_cast(bf16x8, pw);
#pragma unroll
                for (int dt = 0; dt < 4; ++dt) { const unsigned char* vp = sv + (dt * 32 + lq) * FA_VROW + (16 * s2 + 4 * hh) * 2;
                    const u32x2 lo = *(const u32x2*)vp, hi = *(const u32x2*)(vp + 16);
                    u32x4 w; w.x = lo.x; w.y = lo.y; w.z = hi.x; w.w = hi.y; oT[dt] = MFMA32(__builtin_bit_cast(bf16x8, w), pf, oT[dt]); }
            }
            if (kt + 1 < NKT) FA_LSTORE((kt + 1) & 1)
            __syncthreads();
        }
#undef FA_GLOAD
#undef FA_LSTORE
        const float ltot = lrun + SHFL_XOR(lrun, 32), inv = 1.0f / ltot;
        bf16_t* op = p.ao() + (size_t)(b * NL + qt * 128 + wave * 32 + lq) * D + h * 128;
#pragma unroll
        for (int dt = 0; dt < 4; ++dt)
#pragma unroll
            for (int g4 = 0; g4 < 4; ++g4) { f32x4 v; v[0] = oT[dt][4 * g4] * inv; v[1] = oT[dt][4 * g4 + 1] * inv; v[2] = oT[dt][4 * g4 + 2] * inv; v[3] = oT[dt][4 * g4 + 3] * inv;
                *(u32x2*)(op + dt * 32 + 8 * g4 + 4 * hh) = pack4bf(v); }
    }
}
static_assert(NC % RCH == 0 && NL % RCH == 0, "chunking");
DEVFN int chunk_tok0(int b, int tc) { return tc < NCC ? b * NC + tc * RCH : TC + b * NL + (tc - NCC) * RCH; }
DEVFN float ret_lg2(int h) { return log2f(1.0f - exp2f(-5.0f - (float)h)); }
DEVFN bf16_t* retS_ptr(const Params& p, int b, int h, int dir, int tc) { return p.retS() + ((((size_t)(b * 4 + h) * 2 + dir) * NCH + tc) * 128) * 64; }
DEVFN int r_ktoff(int dk, int tok) { return dk * 256 + ((((tok >> 3) ^ (dk & 15)) << 4) | ((tok & 7) << 1)); }
DEVFN int r_vtoff(int dv, int tok) { return 32768 + dv * 256 + ((((tok >> 2) ^ (dv & 31)) << 3) | ((tok & 3) << 1)); }
DEVNI void bk_ret_delta(const Params& p, unsigned char* lds) {
    const int tid = TIDX, lane = tid & 63, wave = tid >> 6, lq = lane & 31, hh = lane >> 5;
    for (int it = blockIdx.x; it < NB * 4 * NCH; it += gridDim.x) {
        const int tc = it % NCH, h = (it / NCH) % 4, b = it / (NCH * 4); const int tok0 = chunk_tok0(b, tc); const float lg = ret_lg2(h);
        __syncthreads();
        { const int j = tid & 127, part = tid >> 7; const bf16_t* row = p.pret() + (size_t)(tok0 + j) * NRET;
          const float df = exp2f(lg * (float)(127 - j)), db = exp2f(lg * (float)j);
          for (int c = part * 32; c < part * 32 + 32; ++c) { const float kv = bf2f(row[256 + h * 64 + c]); *(bf16_t*)(lds + r_ktoff(c, j)) = f2bf(kv * df); *(bf16_t*)(lds + 16384 + r_ktoff(c, j)) = f2bf(kv * db); }
          for (int c = part * 64; c < part * 64 + 64; ++c) *(bf16_t*)(lds + r_vtoff(c, j)) = row[512 + h * 128 + c]; }
        __syncthreads();
#pragma unroll
        for (int dir = 0; dir < 2; ++dir) {
            f32x16 acc[2];
#pragma unroll
            for (int mt = 0; mt < 2; ++mt)
#pragma unroll
                for (int r = 0; r < 16; ++r) acc[mt][r] = 0.f;
#pragma unroll
            for (int ks = 0; ks < 8; ++ks) {
                const int t0 = 16 * ks + 8 * hh, dv = wave * 32 + lq;
                const u32x2 v0 = *(const u32x2*)(lds + r_vtoff(dv, t0)), v1 = *(const u32x2*)(lds + r_vtoff(dv, t0 + 4));
                u32x4 vw; vw.x = v0.x; vw.y = v0.y; vw.z = v1.x; vw.w = v1.y; const bf16x8 vf = __builtin_bit_cast(bf16x8, vw);
#pragma unroll
                for (int mt = 0; mt < 2; ++mt) { const bf16x8 kf = *(const bf16x8*)(lds + dir * 16384 + r_ktoff(mt * 32 + lq, t0)); acc[mt] = MFMA32(kf, vf, acc[mt]); }
            }
            bf16_t* dst = retS_ptr(p, b, h, dir, tc) + (size_t)(wave * 32 + lq) * 64;
#pragma unroll
            for (int mt = 0; mt < 2; ++mt)
#pragma unroll
                for (int g4 = 0; g4 < 4; ++g4) { f32x4 v; v[0] = acc[mt][4 * g4]; v[1] = acc[mt][4 * g4 + 1]; v[2] = acc[mt][4 * g4 + 2]; v[3] = acc[mt][4 * g4 + 3];
                    *(u32x2*)(dst + mt * 32 + 8 * g4 + 4 * hh) = pack4bf(v); }
        }
    }
}
DEVFN int ret_order(int dir, int j) { return dir == 0 ? j : (j < NCC ? NCC - 1 - j : NCC + (NCH - 1 - j)); }
DEVNI void bk_ret_prefix(const Params& p, unsigned char* lds) {
    (void)lds;
    for (int it = blockIdx.x; it < NB * 4 * 2 * 8; it += gridDim.x) {
        const int sl = it % 8, dir = (it / 8) % 2, h = (it / 16) % 4, b = it / 64; const float g128 = exp2f(ret_lg2(h) * 128.f);
        const int e0 = sl * 1024 + threadIdx.x * 4; f32x4 st = (f32x4){0.f, 0.f, 0.f, 0.f};
        for (int j = 0; j < NCH; ++j) { bf16_t* q = retS_ptr(p, b, h, dir, ret_order(dir, j)) + e0; const u32x2 dw = *(const u32x2*)q;
            f32x4 d; d[0] = __builtin_bit_cast(float, dw.x << 16); d[1] = __builtin_bit_cast(float, dw.x & 0xffff0000u); d[2] = __builtin_bit_cast(float, dw.y << 16); d[3] = __builtin_bit_cast(float, dw.y & 0xffff0000u);
            *(u32x2*)q = pack4bf(st); st = st * g128 + d; }
    }
}
DEVNI void bk_ret_out(const Params& p, unsigned char* lds) {
    const int tid = TIDX, lane = tid & 63, wave = tid >> 6, lq = lane & 31, hh = lane >> 5;
    for (int it = blockIdx.x; it < NB * 4 * NCH; it += gridDim.x) {
        const int tc = it % NCH, h = (it / NCH) % 4, b = it / (NCH * 4); const int tok0 = chunk_tok0(b, tc); const float lg = ret_lg2(h);
        __syncthreads();
        { for (int c = tid; c < 1024; c += 256) { const int row = c >> 3, ch = c & 7; *(u32x4*)(lds + row * 128 + ((ch ^ ((row >> 1) & 7)) << 4)) = *(const u32x4*)(p.pret() + (size_t)(tok0 + row) * NRET + 256 + h * 64 + ch * 8); }
          const int j = tid & 127, part = tid >> 7; const bf16_t* row = p.pret() + (size_t)(tok0 + j) * NRET;
          for (int c = part * 64; c < part * 64 + 64; ++c) *(bf16_t*)(lds + r_vtoff(c, j)) = row[512 + h * 128 + c]; }
        const int qi = wave * 32 + lq; bf16x8 qf[4];
        { const bf16_t* qp = p.pret() + (size_t)(tok0 + qi) * NRET + h * 64 + 8 * hh;
#pragma unroll
          for (int ks = 0; ks < 4; ++ks) qf[ks] = *(const bf16x8*)(qp + ks * 16); }
        __syncthreads();
        f32x16 oT[4];
#pragma unroll
        for (int dt = 0; dt < 4; ++dt)
#pragma unroll
            for (int r = 0; r < 16; ++r) oT[dt][r] = 0.f;
#pragma unroll 1
        for (int dir = 0; dir < 2; ++dir) {
            const bf16_t* S = retS_ptr(p, b, h, dir, tc); const float sc = exp2f(lg * (float)(dir == 0 ? qi + 1 : 128 - qi));
#pragma unroll
            for (int dt = 0; dt < 4; ++dt) { f32x16 x;
#pragma unroll
                for (int r = 0; r < 16; ++r) x[r] = 0.f;
#pragma unroll
                for (int ks = 0; ks < 4; ++ks) x = MFMA32(*(const bf16x8*)(S + (size_t)(dt * 32 + lq) * 64 + ks * 16 + 8 * hh), qf[ks], x);
                oT[dt] = oT[dt] + x * sc; }
        }
#pragma unroll 1
        for (int kb = 0; kb < 4; ++kb) {
            f32x16 sT;
#pragma unroll
            for (int r = 0; r < 16; ++r) sT[r] = 0.f;
#pragma unroll
            for (int ks = 0; ks < 4; ++ks) { const int row = kb * 32 + lq, ch = ks * 2 + hh; const bf16x8 kf = *(const bf16x8*)(lds + row * 128 + ((ch ^ ((row >> 1) & 7)) << 4)); sT = MFMA32(kf, qf[ks], sT); }
#pragma unroll
            for (int r = 0; r < 16; ++r) { const int key = kb * 32 + (r & 3) + 8 * (r >> 2) + 4 * hh; const int dd = key > qi ? key - qi : qi - key; sT[r] *= FAST_EXP2(lg * (float)dd); }
#pragma unroll
            for (int s2 = 0; s2 < 2; ++s2) {
                u32x4 pw; pw.x = pack2bf(sT[8 * s2], sT[8 * s2 + 1]); pw.y = pack2bf(sT[8 * s2 + 2], sT[8 * s2 + 3]); pw.z = pack2bf(sT[8 * s2 + 4], sT[8 * s2 + 5]); pw.w = pack2bf(sT[8 * s2 + 6], sT[8 * s2 + 7]);
                const bf16x8 pf = __builtin_bit_cast(bf16x8, pw);
                const int t0 = kb * 32 + 16 * s2 + 4 * hh;
#pragma unroll
                for (int dt = 0; dt < 4; ++dt) { const int dv = dt * 32 + lq; const u32x2 v0 = *(const u32x2*)(lds + r_vtoff(dv, t0)), v1 = *(const u32x2*)(lds + r_vtoff(dv, t0 + 8));
                    u32x4 vw; vw.x = v0.x; vw.y = v0.y; vw.z = v1.x; vw.w = v1.y; oT[dt] = MFMA32(__builtin_bit_cast(bf16x8, vw), pf, oT[dt]); }
            }
        }
        float ss = 0.f;
#pragma unroll
        for (int dt = 0; dt < 4; ++dt)
#pragma unroll
            for (int r = 0; r < 16; ++r) ss += oT[dt][r] * oT[dt][r];
        ss += SHFL_XOR(ss, 32);
        const float rs = rsqrtf(ss / 128.f + EPS);
        const bf16_t* gp = p.pret() + (size_t)(tok0 + qi) * NRET + 1024 + h * 128; bf16_t* op = p.mixr() + (size_t)(tok0 + qi) * 512 + h * 128;
#pragma unroll
        for (int dt = 0; dt < 4; ++dt)
#pragma unroll
            for (int g4 = 0; g4 < 4; ++g4) { const int d0 = dt * 32 + 8 * g4 + 4 * hh; const u32x2 gw = *(const u32x2*)(gp + d0);
                f32x4 v; v[0] = oT[dt][4 * g4] * rs * fast_silu(bf2f((bf16_t)(gw.x & 0xffff))); v[1] = oT[dt][4 * g4 + 1] * rs * fast_silu(bf2f((bf16_t)(gw.x >> 16)));
                v[2] = oT[dt][4 * g4 + 2] * rs * fast_silu(bf2f((bf16_t)(gw.y & 0xffff))); v[3] = oT[dt][4 * g4 + 3] * rs * fast_silu(bf2f((bf16_t)(gw.y >> 16)));
                *(u32x2*)(op + d0) = pack4bf(v); }
    }
}


#ifndef HOST_EMU
template <int CTRL> DEVFN float dpp_f(float v) { return __builtin_bit_cast(float, __builtin_amdgcn_update_dpp(0, __builtin_bit_cast(int, v), CTRL, 0xf, 0xf, true)); }
#define RED8(v) { v += dpp_f<0xB1>(v); v += dpp_f<0x4E>(v); v += dpp_f<0x141>(v); }
#define QUAD_XOR1(v) dpp_f<0xB1>(v)
#define QUAD_XOR2(v) dpp_f<0x4E>(v)
#else
#define RED8(v) { v += SHFL_XOR(v, 1); v += SHFL_XOR(v, 2); v += SHFL_XOR(v, 4); }
#define QUAD_XOR1(v) SHFL_XOR(v, 1)
#define QUAD_XOR2(v) SHFL_XOR(v, 2)
#endif
#ifndef HOST_EMU
#define RED16(v) { RED8(v) v += dpp_f<0x140>(v); }
#else
#define RED16(v) { RED8(v) v += SHFL_XOR(v, 8); }
#endif
#define RED64(v) { RED16(v) v += SHFL_XOR(v, 16); v += SHFL_XOR(v, 32); }
constexpr int SCH = 16, SC_IN = (5 * SCH * 64 + SCH * 16) * 4, SC_STAGE = SC_IN, SC_YOFF = 2 * SC_IN, SC_YBYTES = SCH * 16 * 16 * 4;
static_assert(SC_YOFF + SC_YBYTES <= LDS_BYTES, "scan LDS");
struct ScanIn { f32x4 kk, r, w, a, t; float vt; };
DEVFN void scan_load(ScanIn& x, const float* sb, int st, int kc, int vrow) {
    const float* q = sb + st * 64 + kc * 4;
    x.kk = *(const f32x4*)(q); x.r = *(const f32x4*)(q + SCH * 64); x.w = *(const f32x4*)(q + 2 * SCH * 64); x.a = *(const f32x4*)(q + 3 * SCH * 64); x.t = *(const f32x4*)(q + 4 * SCH * 64);
    x.vt = sb[5 * SCH * 64 + st * 16 + vrow];
}
#define V2(v4, i) ((f32x2){(v4)[2 * (i)], (v4)[2 * (i) + 1]})
DEVFN float scan_step(f32x2 (&S)[2], const ScanIn& x) {
    f32x2 d = S[0] * V2(x.kk, 0); d = S[1] * V2(x.kk, 1) + d;
    float sa = d[0] + d[1];
    RED16(sa)
    const f32x2 vt2 = (f32x2){x.vt, x.vt}, nsa = (f32x2){-sa, -sa};
    S[0] = S[0] * V2(x.w, 0) + (nsa * V2(x.a, 0) + vt2 * V2(x.t, 0));
    S[1] = S[1] * V2(x.w, 1) + (nsa * V2(x.a, 1) + vt2 * V2(x.t, 1));
    f32x2 y = S[0] * V2(x.r, 0); y = S[1] * V2(x.r, 1) + y;
    return y[0] + y[1];
}
DEVNI void bk_rwkv_scan(const Params& p, unsigned char* lds) {
    const int tid = TIDX, lane = tid & 63, wave = tid >> 6, kc = lane & 15, vrow = wave * 4 + (lane >> 4);
    for (int it = blockIdx.x; it < NB * 8 * 2 * 4; it += gridDim.x) {
        const int quarter = it & 3, dir = (it >> 2) & 1, h = (it >> 3) & 7, b = it >> 6;
        const bf16_t* a_kk = p.fkk(); const bf16_t* a_r = p.fr(); const bf16_t* a_w = dir ? p.fomw1() : p.fomw0(); const bf16_t* a_a = dir ? p.fkka1() : p.fkka0(); const bf16_t* a_t = dir ? p.fkt1() : p.fkt0();
        bf16_t* yout = (dir ? p.ybw() : p.yf()) + h * 64 + quarter * 16 + (tid & 15);
        f32x2 S[2]; S[0] = (f32x2){0.f, 0.f}; S[1] = (f32x2){0.f, 0.f};
        u32x4 g0, g1, g2, gv; g0 = g1 = g2 = gv = (u32x4){0u, 0u, 0u, 0u};
        const int sst = (tid % 128) / 8, sch8 = (tid % 8) * 8;
        const bf16_t* pa0 = (tid < 128 ? a_kk : a_r) + h * 64 + sch8; const bf16_t* pa1 = (tid < 128 ? a_w : a_a) + h * 64 + sch8; const bf16_t* pa2 = a_t + h * 64 + sch8;
        const bf16_t* pv = p.fv() + h * 64 + quarter * 16 + (tid % 2) * 8; const int vst = (tid - 128) / 2;
#define SC_GLOAD(ch) { const int u0_ = (ch) * SCH; const size_t to_ = (size_t)scan_tok(b, dir, u0_ + sst) * 512; g0 = *(const u32x4*)(pa0 + to_); g1 = *(const u32x4*)(pa1 + to_); \
            if (tid < 128) g2 = *(const u32x4*)(pa2 + to_); else if (tid < 160) gv = *(const u32x4*)(pv + (size_t)scan_tok(b, dir, u0_ + vst) * 512); }
#define SC_CVT8(dst, srcv, isw) { const u32x4 w_ = (srcv); float* d_ = (dst); const float o_ = (isw) ? 1.0f : 0.0f, m_ = (isw) ? -1.0f : 1.0f; f32x4 lo_, hi_; \
            lo_[0] = o_ + m_ * __builtin_bit_cast(float, w_.x << 16); lo_[1] = o_ + m_ * __builtin_bit_cast(float, w_.x & 0xffff0000u); lo_[2] = o_ + m_ * __builtin_bit_cast(float, w_.y << 16); lo_[3] = o_ + m_ * __builtin_bit_cast(float, w_.y & 0xffff0000u); \
            hi_[0] = o_ + m_ * __builtin_bit_cast(float, w_.z << 16); hi_[1] = o_ + m_ * __builtin_bit_cast(float, w_.z & 0xffff0000u); hi_[2] = o_ + m_ * __builtin_bit_cast(float, w_.w << 16); hi_[3] = o_ + m_ * __builtin_bit_cast(float, w_.w & 0xffff0000u); \
            *(f32x4*)d_ = lo_; *(f32x4*)(d_ + 4) = hi_; }
#define SC_LSTORE(st) { float* sb_ = (float*)(lds + (st) * SC_STAGE); \
            SC_CVT8(sb_ + ((tid / 128) * SCH + sst) * 64 + sch8, g0, false) \
            SC_CVT8(sb_ + ((2 + tid / 128) * SCH + sst) * 64 + sch8, g1, tid < 128) \
            if (tid < 128) { SC_CVT8(sb_ + (4 * SCH + sst) * 64 + sch8, g2, false) } \
            else if (tid < 160) { SC_CVT8(sb_ + 5 * SCH * 64 + vst * 16 + (tid % 2) * 8, gv, false) } }
        __syncthreads();
        SC_GLOAD(0) SC_LSTORE(0)
        __syncthreads();
        constexpr int NCHK = SQ / SCH;
        float* yp = (float*)(lds + SC_YOFF);
        for (int ch = 0; ch <= NCHK; ++ch) {
            if (ch > 0) { const f32x4* q4 = (const f32x4*)(yp + tid * 16); const f32x4 s4 = (q4[0] + q4[1]) + (q4[2] + q4[3]);
                yout[(size_t)scan_tok(b, dir, (ch - 1) * SCH + (tid >> 4)) * 512] = f2bf((s4[0] + s4[1]) + (s4[2] + s4[3])); }
            if (ch == NCHK) break;
            __syncthreads();
            if (ch + 1 < NCHK) SC_GLOAD(ch + 1)
            const float* sb = (const float*)(lds + (ch & 1) * SC_STAGE);
            ScanIn x[3]; scan_load(x[0], sb, 0, kc, vrow); scan_load(x[1], sb, 1, kc, vrow);
#pragma unroll
            for (int st = 0; st < SCH; ++st) {
                if (st + 2 < SCH) scan_load(x[(st + 2) % 3], sb, st + 2, kc, vrow);
                yp[(st * 16 + vrow) * 16 + kc] = scan_step(S, x[st % 3]);
            }
            if (ch + 1 < NCHK) SC_LSTORE((ch + 1) & 1)
            __syncthreads();
        }
#undef SC_GLOAD
#undef SC_CVT8
#undef SC_LSTORE
    }
}


constexpr int CK_RAW = 0;
constexpr int CK_AT = 24576, CK_RT = CK_AT + 2048, CK_BT = CK_RT + 2048, CK_KT = CK_BT + 2048;
constexpr int CK_BCT = CK_KT + 2048, CK_KCT = CK_BCT + 2048, CK_VT = CK_KCT + 2048;
constexpr int CK_CC = CK_VT + 2048;
constexpr int CK_MBQ = CK_CC + 256;
constexpr int CK_MKT = CK_MBQ + 1024, CK_NKT = CK_MKT + 512, CK_NBT = CK_NKT + 512;
constexpr int CK_G0 = CK_NBT + 512;
constexpr int CK_SA = CK_G0 + 4096;
constexpr int CK_Y = CK_SA + 2048;
constexpr int CK_END = CK_Y + 4096;
static_assert(CK_END <= LDS_BYTES, "chunked scan LDS");
DEVFN bf16x8 ck_frag_perm(const unsigned char* img, int row, int m, int g) {
    const u32x2 lo = *(const u32x2*)(img + row * 128 + (32 * m + 4 * g) * 2), hi = *(const u32x2*)(img + row * 128 + (32 * m + 16 + 4 * g) * 2);
    u32x4 w; w.x = lo.x; w.y = lo.y; w.z = hi.x; w.w = hi.y; return __builtin_bit_cast(bf16x8, w);
}
DEVFN bf16x8 ck_frag16(const unsigned char* img, int row, int g) {
    u32x4 w = (u32x4){0u, 0u, 0u, 0u}; if (g < 2) w = *(const u32x4*)(img + row * 32 + g * 16); return __builtin_bit_cast(bf16x8, w);
}
template <int VARC = 0> DEVNI void bk_rwkv_chunk(const Params& p, unsigned char* lds) {
    const int tid = TIDX, lane = tid & 63, wave = tid >> 6, fr = lane & 15, g = lane >> 4;
    for (int it = blockIdx.x; it < NB * 8 * 2; it += gridDim.x) {
        const int dir = it & 1, h = (it >> 1) & 7, b = it >> 4;
        const bf16_t* arr[6] = {p.fkk(), p.fr(), dir ? p.fomw1() : p.fomw0(), dir ? p.fkka1() : p.fkka0(), dir ? p.fkt1() : p.fkt0(), p.fv()};
        bf16_t* yout = (dir ? p.ybw() : p.yf()) + h * 64;
        f32x4 X[4];
#pragma unroll
        for (int j = 0; j < 4; ++j) X[j] = (f32x4){0.f, 0.f, 0.f, 0.f};
        u32x4 gr[3];
#define CK_GLOAD(ch) { _Pragma("unroll") for (int i = 0; i < 3; ++i) { const int c_ = tid + 256 * i, a_ = c_ >> 7, st_ = (c_ & 127) >> 3, c8_ = c_ & 7; \
            gr[i] = *(const u32x4*)(arr[a_] + (size_t)scan_tok(b, dir, (ch) * 16 + st_) * 512 + h * 64 + c8_ * 8); } }
#define CK_LSTORE(bf) { _Pragma("unroll") for (int i = 0; i < 3; ++i) { const int c_ = tid + 256 * i; *(u32x4*)(lds + CK_RAW + (bf) * 12288 + c_ * 16) = gr[i]; } }
        constexpr int NCHK = SQ / 16;
        __syncthreads();
        CK_GLOAD(0) CK_LSTORE(0)
        for (int ch = 0; ch < NCHK; ++ch) {
            __syncthreads();
            if (ch > 0) { const int t_ = tid >> 4, v4_ = (tid & 15) * 4;
                *(u32x2*)(yout + (size_t)scan_tok(b, dir, (ch - 1) * 16 + t_) * 512 + v4_) = *(const u32x2*)(lds + CK_Y + ((ch - 1) & 1) * 2048 + (t_ * 64 + v4_) * 2); }
            if (ch + 1 < NCHK) CK_GLOAD(ch + 1)
            if (VARC != 2) { const bf16_t* raw = (const bf16_t*)(lds + CK_RAW + (ch & 1) * 12288); const int k = lane;
              float c = 1.f, cprev[4], ccur[4];
#pragma unroll
              for (int t = 0; t < 16; ++t) { const float cp = c; c *= 1.0f - bf2f(raw[(2 * 16 + t) * 64 + k]); if ((t >> 2) == wave) { cprev[t & 3] = cp; ccur[t & 3] = c; } }
              const float c16 = c; float bcv[4], kcv[4], vv[4];
#pragma unroll
              for (int q = 0; q < 4; ++q) { const int t = 4 * wave + q; const float rc = FAST_RCP(ccur[q]);
                  const float al = bf2f(raw[(0 * 16 + t) * 64 + k]), rr = bf2f(raw[(1 * 16 + t) * 64 + k]), be = bf2f(raw[(3 * 16 + t) * 64 + k]), ka = bf2f(raw[(4 * 16 + t) * 64 + k]);
                  *(bf16_t*)(lds + CK_AT + (t * 64 + k) * 2) = f2bf(al * cprev[q]); *(bf16_t*)(lds + CK_RT + (t * 64 + k) * 2) = f2bf(rr * ccur[q]);
                  const float bt = be * rc, kt = ka * rc; *(bf16_t*)(lds + CK_BT + (t * 64 + k) * 2) = f2bf(bt); *(bf16_t*)(lds + CK_KT + (t * 64 + k) * 2) = f2bf(kt);
                  bcv[q] = bt * c16; kcv[q] = kt * c16; vv[q] = bf2f(raw[(5 * 16 + t) * 64 + k]); }
              { u32x2 w; w.x = pack2bf(bcv[0], bcv[1]); w.y = pack2bf(bcv[2], bcv[3]); *(u32x2*)(lds + CK_BCT + k * 32 + wave * 8) = w; }
              { u32x2 w; w.x = pack2bf(kcv[0], kcv[1]); w.y = pack2bf(kcv[2], kcv[3]); *(u32x2*)(lds + CK_KCT + k * 32 + wave * 8) = w; }
              { u32x2 w; w.x = pack2bf(vv[0], vv[1]); w.y = pack2bf(vv[2], vv[3]); *(u32x2*)(lds + CK_VT + k * 32 + wave * 8) = w; }
              if (wave == 0) *(float*)(lds + CK_CC + k * 4) = c16; }
            __syncthreads();
            if (VARC != 2) { const unsigned char* ai = lds + ((wave == 0 || wave == 1) ? CK_AT : CK_RT); const unsigned char* bi = lds + ((wave == 0 || wave == 2) ? CK_BT : CK_KT);
              f32x4 d = (f32x4){0.f, 0.f, 0.f, 0.f};
#pragma unroll
              for (int ks = 0; ks < 2; ++ks) d = MFMA16(*(const bf16x8*)(ai + fr * 128 + (32 * ks + 8 * g) * 2), *(const bf16x8*)(bi + fr * 128 + (32 * ks + 8 * g) * 2), d);
              const int i = fr;
#pragma unroll
              for (int r = 0; r < 4; ++r) { const int t = 4 * g + r; const bool keep = (wave < 2) ? (i < t) : (i <= t); const float val = keep ? d[r] : 0.f;
                  if (wave == 0) *(float*)(lds + CK_MBQ + ((t * 4 + (i & 3)) * 4 + (i >> 2)) * 4) = val;
                  else *(bf16_t*)(lds + (wave == 1 ? CK_MKT : wave == 2 ? CK_NBT : CK_NKT) + (t * 16 + i) * 2) = f2bf(val); } }
            __syncthreads();
            if (VARC == 3) { if (ch + 1 < NCHK) CK_LSTORE((ch + 1) & 1) continue; }
            bf16x8 sb[2];
#pragma unroll
            for (int m = 0; m < 2; ++m) { u32x4 w; w.x = pack2bf(X[2 * m][0], X[2 * m][1]); w.y = pack2bf(X[2 * m][2], X[2 * m][3]); w.z = pack2bf(X[2 * m + 1][0], X[2 * m + 1][1]); w.w = pack2bf(X[2 * m + 1][2], X[2 * m + 1][3]); sb[m] = __builtin_bit_cast(bf16x8, w); }
            const bf16x8 vb = ck_frag16(lds + CK_VT, 16 * wave + fr, g);
            { f32x4 d = (f32x4){0.f, 0.f, 0.f, 0.f};
#pragma unroll
              for (int m = 0; m < 2; ++m) d = MFMA16(ck_frag_perm(lds + CK_AT, fr, m, g), sb[m], d);
              d = MFMA16(ck_frag16(lds + CK_MKT, fr, g), vb, d);
              *(f32x4*)(lds + CK_G0 + ((16 * wave + fr) * 16 + 4 * g) * 4) = d; }
            WAVE_SYNC()
            { const int q = lane & 3, v = 16 * wave + (lane >> 2); float sq[4] = {0.f, 0.f, 0.f, 0.f};
#pragma unroll
              for (int t = 0; t < (VARC == 1 ? 1 : 16); ++t) { const f32x4 mb = *(const f32x4*)(lds + CK_MBQ + (t * 4 + q) * 16);
                  float part = (sq[0] * mb[0] + sq[1] * mb[1]) + (sq[2] * mb[2] + sq[3] * mb[3]);
                  part += QUAD_XOR1(part); part += QUAD_XOR2(part);
                  const float val = *(const float*)(lds + CK_G0 + (v * 16 + t) * 4) - part;
                  if (q == (t & 3)) sq[t >> 2] = val; }
#pragma unroll
              for (int m = 0; m < 4; ++m) *(bf16_t*)(lds + CK_SA + (v * 16 + 4 * m + q) * 2) = f2bf(-sq[m]); }
            WAVE_SYNC()
            { const bf16x8 nsa = ck_frag16(lds + CK_SA, 16 * wave + fr, g);
              f32x4 y = (f32x4){0.f, 0.f, 0.f, 0.f};
#pragma unroll
              for (int m = 0; m < 2; ++m) y = MFMA16(ck_frag_perm(lds + CK_RT, fr, m, g), sb[m], y);
              y = MFMA16(ck_frag16(lds + CK_NKT, fr, g), vb, y);
              y = MFMA16(ck_frag16(lds + CK_NBT, fr, g), nsa, y);
#pragma unroll
              for (int r = 0; r < 4; ++r) *(bf16_t*)(lds + CK_Y + (ch & 1) * 2048 + ((4 * g + r) * 64 + 16 * wave + fr) * 2) = f2bf(y[r]);
#pragma unroll
              for (int j = 0; j < 4; ++j) { const f32x4 cc = *(const f32x4*)(lds + CK_CC + (16 * j + 4 * g) * 4); f32x4 d = X[j] * cc;
                  d = MFMA16(ck_frag16(lds + CK_BCT, 16 * j + fr, g), nsa, d);
                  d = MFMA16(ck_frag16(lds + CK_KCT, 16 * j + fr, g), vb, d); X[j] = d; } }
            if (ch + 1 < NCHK) CK_LSTORE((ch + 1) & 1)
        }
        __syncthreads();
        { const int t_ = tid >> 4, v4_ = (tid & 15) * 4;
          *(u32x2*)(yout + (size_t)scan_tok(b, dir, (NCHK - 1) * 16 + t_) * 512 + v4_) = *(const u32x2*)(lds + CK_Y + ((NCHK - 1) & 1) * 2048 + (t_ * 64 + v4_) * 2); }
#undef CK_GLOAD
#undef CK_LSTORE
    }
}


constexpr int C2_RAW = 0;
constexpr int C2_IMG = 24576, C2_IMGSZ = 6 * 2048 + 512 + 256;
constexpr int C2_AT = 0, C2_RT = 2048, C2_BT = 4096, C2_KT = 6144, C2_BCT = 8192, C2_KCT = 10240, C2_VT = 12288, C2_CC = 12800;
constexpr int C2_GRAM = C2_IMG + 2 * C2_IMGSZ, C2_GRAMSZ = 2560;
constexpr int C2_MBQ = 0, C2_MKT = 1024, C2_NKT = 1536, C2_NBT = 2048;
constexpr int C2_G0 = C2_GRAM + 2 * C2_GRAMSZ, C2_SA = C2_G0 + 1024, C2_Y = C2_SA + 512, C2_CNT = C2_Y + 2 * 512, C2_END = C2_CNT + 16;
static_assert(C2_END <= LDS_BYTES, "chunked scan LDS");
template <int VARP = 0> DEVNI void bk_rwkv_chunk2(const Params& p, unsigned char* lds) {
    const int tid = TIDX, lane = tid & 63, wave = tid >> 6, fr = lane & 15, g = lane >> 4;
    constexpr int NCHK = SQ / 16;
    for (int it0 = blockIdx.x; it0 < NB * 8 * 2 * 4; it0 += gridDim.x) {
        const int it = (gridDim.x % 32 == 0) ? (((it0 & 7) + 8 * (it0 >> 5)) * 4 + ((it0 >> 3) & 3)) : it0;
        const int vt = it & 3, dir = (it >> 2) & 1, h = (it >> 3) & 7, b = it >> 6;
        const bf16_t* arr[6] = {p.fkk(), p.fr(), dir ? p.fomw1() : p.fomw0(), dir ? p.fkka1() : p.fkka0(), dir ? p.fkt1() : p.fkt0(), p.fv()};
        bf16_t* yout = (dir ? p.ybw() : p.yf()) + h * 64 + vt * 16;
        f32x4 X[4];
#pragma unroll
        for (int j = 0; j < 4; ++j) X[j] = (f32x4){0.f, 0.f, 0.f, 0.f};
        u32x4 grA[3], grB[3];
#define C2_GLOAD(ch, gr) { _Pragma("unroll") for (int i = 0; i < 3; ++i) { const int c_ = tid + 256 * i, a_ = c_ >> 7, st_ = (c_ & 127) >> 3, c8_ = c_ & 7; \
            gr[i] = *(const u32x4*)(arr[a_] + (size_t)scan_tok(b, dir, (ch) * 16 + st_) * 512 + h * 64 + c8_ * 8); } }
#define C2_LSTORE(bf, gr) { _Pragma("unroll") for (int i = 0; i < 3; ++i) { const int c_ = tid + 256 * i; *(u32x4*)(lds + C2_RAW + (bf) * 12288 + c_ * 16) = gr[i]; } }
#define C2_PREP(ch, ib) if (wave > 0) { const bf16_t* raw = (const bf16_t*)(lds + C2_RAW + ((ch) & 1) * 12288); unsigned char* im = lds + C2_IMG + (ib) * C2_IMGSZ; const int k = lane; \
            float wv[16], xa[16], xb[16]; \
            _Pragma("unroll") for (int t = 0; t < 16; ++t) { wv[t] = 1.0f - bf2f(raw[(2 * 16 + t) * 64 + k]); xa[t] = bf2f(raw[((wave == 1 ? 0 : wave == 2 ? 3 : 4) * 16 + t) * 64 + k]); xb[t] = (wave == 1) ? bf2f(raw[(1 * 16 + t) * 64 + k]) : 0.f; } \
            float c = 1.f, cc[17]; cc[0] = 1.f; \
            _Pragma("unroll") for (int t = 0; t < 16; ++t) { c *= wv[t]; cc[t + 1] = c; } \
            if (wave == 1) { _Pragma("unroll") for (int t = 0; t < 16; ++t) { *(bf16_t*)(im + C2_AT + (t * 64 + k) * 2) = f2bf(xa[t] * cc[t]); *(bf16_t*)(im + C2_RT + (t * 64 + k) * 2) = f2bf(xb[t] * cc[t + 1]); } \
                *(float*)(im + C2_CC + k * 4) = c; } \
            else { float sc[16]; \
                _Pragma("unroll") for (int t = 0; t < 16; ++t) { const float xt = xa[t] * FAST_RCP(cc[t + 1]); *(bf16_t*)(im + (wave == 2 ? C2_BT : C2_KT) + (t * 64 + k) * 2) = f2bf(xt); sc[t] = xt * c; } \
                u32x4 w0, w1; w0.x = pack2bf(sc[0], sc[1]); w0.y = pack2bf(sc[2], sc[3]); w0.z = pack2bf(sc[4], sc[5]); w0.w = pack2bf(sc[6], sc[7]); \
                w1.x = pack2bf(sc[8], sc[9]); w1.y = pack2bf(sc[10], sc[11]); w1.z = pack2bf(sc[12], sc[13]); w1.w = pack2bf(sc[14], sc[15]); \
                *(u32x4*)(im + (wave == 2 ? C2_BCT : C2_KCT) + k * 32) = w0; *(u32x4*)(im + (wave == 2 ? C2_BCT : C2_KCT) + k * 32 + 16) = w1; \
                if (wave == 3 && lane < 16) { bf16_t vv[16]; _Pragma("unroll") for (int t = 0; t < 16; ++t) vv[t] = raw[(5 * 16 + t) * 64 + vt * 16 + lane]; \
                    u32x4 v0, v1; v0.x = vv[0] | ((unsigned)vv[1] << 16); v0.y = vv[2] | ((unsigned)vv[3] << 16); v0.z = vv[4] | ((unsigned)vv[5] << 16); v0.w = vv[6] | ((unsigned)vv[7] << 16); \
                    v1.x = vv[8] | ((unsigned)vv[9] << 16); v1.y = vv[10] | ((unsigned)vv[11] << 16); v1.z = vv[12] | ((unsigned)vv[13] << 16); v1.w = vv[14] | ((unsigned)vv[15] << 16); \
                    *(u32x4*)(im + C2_VT + lane * 32) = v0; *(u32x4*)(im + C2_VT + lane * 32 + 16) = v1; } } }
#define C2_GRAM1(ib, AI, BI, KIND) { const unsigned char* im = lds + C2_IMG + (ib) * C2_IMGSZ; unsigned char* gm = lds + C2_GRAM + (ib) * C2_GRAMSZ; f32x4 d = (f32x4){0.f, 0.f, 0.f, 0.f}; \
            _Pragma("unroll") for (int ks = 0; ks < 2; ++ks) d = MFMA16(*(const bf16x8*)(im + (AI) + fr * 128 + (32 * ks + 8 * g) * 2), *(const bf16x8*)(im + (BI) + fr * 128 + (32 * ks + 8 * g) * 2), d); \
            _Pragma("unroll") for (int r = 0; r < 4; ++r) { const int t = 4 * g + r, i = fr; const bool keep = ((KIND) < 2) ? (i < t) : (i <= t); const float val = keep ? d[r] : 0.f; \
                if ((KIND) == 0) *(float*)(gm + C2_MBQ + ((t * 4 + (i & 3)) * 4 + (i >> 2)) * 4) = val; \
                else *(bf16_t*)(gm + ((KIND) == 1 ? C2_MKT : (KIND) == 2 ? C2_NBT : C2_NKT) + (t * 16 + i) * 2) = f2bf(val); } }
#define C2_GRAMS(ib) { if (wave == 1) C2_GRAM1(ib, C2_AT, C2_BT, 0) else if (wave == 2) { C2_GRAM1(ib, C2_AT, C2_KT, 1) C2_GRAM1(ib, C2_RT, C2_BT, 2) } else if (wave == 3) C2_GRAM1(ib, C2_RT, C2_KT, 3) }
        auto c2_body = [&](const int ch, const int ib) {
            if (wave == 0 && (VARP == 3 || VARP == 4)) { }
            else if (wave == 0) {
                const unsigned char* im = lds + C2_IMG + ib * C2_IMGSZ; const unsigned char* gm = lds + C2_GRAM + ib * C2_GRAMSZ;
                if (ch > 0 && lane < 32) { const int t_ = lane >> 1, hf = lane & 1;
                    *(u32x4*)(yout + (size_t)scan_tok(b, dir, (ch - 1) * 16 + t_) * 512 + hf * 8) = *(const u32x4*)(lds + C2_Y + ((ch - 1) & 1) * 512 + t_ * 32 + hf * 16); }
                bf16x8 sb[2];
#pragma unroll
                for (int m = 0; m < 2; ++m) { u32x4 w; w.x = pack2bf(X[2 * m][0], X[2 * m][1]); w.y = pack2bf(X[2 * m][2], X[2 * m][3]); w.z = pack2bf(X[2 * m + 1][0], X[2 * m + 1][1]); w.w = pack2bf(X[2 * m + 1][2], X[2 * m + 1][3]); sb[m] = __builtin_bit_cast(bf16x8, w); }
                const bf16x8 vb = ck_frag16(im + C2_VT, fr, g);
                const bf16x8 a0 = ck_frag_perm(im + C2_AT, fr, 0, g), a1 = ck_frag_perm(im + C2_AT, fr, 1, g), r0 = ck_frag_perm(im + C2_RT, fr, 0, g), r1 = ck_frag_perm(im + C2_RT, fr, 1, g);
                const bf16x8 mk = ck_frag16(gm + C2_MKT, fr, g), nk = ck_frag16(gm + C2_NKT, fr, g), nb = ck_frag16(gm + C2_NBT, fr, g);
                bf16x8 kcf[4], bcf[4]; f32x4 ccv[4];
#pragma unroll
                for (int j = 0; j < 4; ++j) { kcf[j] = ck_frag16(im + C2_KCT, 16 * j + fr, g); bcf[j] = ck_frag16(im + C2_BCT, 16 * j + fr, g); ccv[j] = *(const f32x4*)(im + C2_CC + (16 * j + 4 * g) * 4); }
                const int q = lane & 3, vv = lane >> 2; f32x4 mbv[16];
#pragma unroll
                for (int t = 0; t < 16; ++t) mbv[t] = *(const f32x4*)(gm + C2_MBQ + (t * 4 + q) * 16);
                f32x4 d = (f32x4){0.f, 0.f, 0.f, 0.f}; d = MFMA16(a0, sb[0], d); d = MFMA16(a1, sb[1], d); d = MFMA16(mk, vb, d);
                f32x4 y = (f32x4){0.f, 0.f, 0.f, 0.f}; y = MFMA16(r0, sb[0], y); y = MFMA16(r1, sb[1], y); y = MFMA16(nk, vb, y);
#pragma unroll
                for (int j = 0; j < 4; ++j) X[j] = MFMA16(kcf[j], vb, X[j] * ccv[j]);
                *(f32x4*)(lds + C2_G0 + (fr * 16 + 4 * g) * 4) = d;
                WAVE_SYNC()
                f32x4 g0v[4];
#pragma unroll
                for (int m = 0; m < 4; ++m) g0v[m] = *(const f32x4*)(lds + C2_G0 + (vv * 16 + 4 * m) * 4);
                float sq[4] = {0.f, 0.f, 0.f, 0.f};
#pragma unroll
                for (int t = 0; t < (VARP == 2 ? 1 : 16); ++t) { float part = (sq[0] * mbv[t][0] + sq[1] * mbv[t][1]) + (sq[2] * mbv[t][2] + sq[3] * mbv[t][3]);
                    part += QUAD_XOR1(part); part += QUAD_XOR2(part);
                    const float val = g0v[t >> 2][t & 3] - part; if (q == (t & 3)) sq[t >> 2] = val; }
#pragma unroll
                for (int m = 0; m < 4; ++m) *(bf16_t*)(lds + C2_SA + (vv * 16 + 4 * m + q) * 2) = f2bf(-sq[m]);
                WAVE_SYNC()
                const bf16x8 nsa = ck_frag16(lds + C2_SA, fr, g);
                y = MFMA16(nb, nsa, y);
#pragma unroll
                for (int j = 0; j < 4; ++j) X[j] = MFMA16(bcf[j], nsa, X[j]);
#pragma unroll
                for (int r = 0; r < 4; ++r) *(bf16_t*)(lds + C2_Y + ib * 512 + ((4 * g + r) * 16 + fr) * 2) = f2bf(y[r]);
            } else {
                if (ch + 1 < NCHK && VARP != 1 && VARP != 4) C2_PREP(ch + 1, ib ^ 1)
                {
                  volatile int* cnt = (volatile int*)(lds + C2_CNT); WAVE_SYNC()
                  if (lane == 0) atomicAdd((int*)(lds + C2_CNT), 1);
                  const int want = 3 * (ch + 2); while (*cnt < want) SPIN_PAUSE();
                  WAVE_SYNC() }
                if (ch + 1 < NCHK && VARP != 1 && VARP != 4) C2_GRAMS(ib ^ 1)
            }
        };
#define C2_BODY(ch, ib) c2_body(ch, ib);
        static_assert(NCHK % 2 == 0 && NCHK >= 4, "chunk pairs");
        __syncthreads();
        C2_GLOAD(0, grA) C2_LSTORE(0, grA)
        C2_GLOAD(1, grB) C2_GLOAD(2, grA)
        if (tid == 0) *(int*)(lds + C2_CNT) = 3;
        __syncthreads();
        C2_PREP(0, 0)
        C2_LSTORE(1, grB)
        __syncthreads();
        C2_GRAMS(0)
        __syncthreads();
#define C2_ITER(ch, GR_LOAD, GR_STORE) { \
            const int ib = (ch) & 1; \
            if ((ch) + 3 < NCHK) C2_GLOAD((ch) + 3, GR_LOAD) \
            C2_BODY(ch, ib) \
            if ((ch) + 2 < NCHK) C2_LSTORE((ch) & 1, GR_STORE) \
            __syncthreads(); }
        for (int ch = 0; ch < NCHK; ch += 2) {
            C2_ITER(ch, grB, grA)
            C2_ITER(ch + 1, grA, grB)
        }
#undef C2_ITER
        if (wave == 0 && lane < 32) { const int t_ = lane >> 1, hf = lane & 1;
            *(u32x4*)(yout + (size_t)scan_tok(b, dir, (NCHK - 1) * 16 + t_) * 512 + hf * 8) = *(const u32x4*)(lds + C2_Y + ((NCHK - 1) & 1) * 512 + t_ * 32 + hf * 16); }
#undef C2_GLOAD
#undef C2_LSTORE
#undef C2_PREP
#undef C2_GRAM1
#undef C2_GRAMS
#undef C2_BODY
    }
}

constexpr int C3_RAW = 0;
constexpr int C3_IMG = 24576, C3_IMGSZ = 6 * 2048 + 1024 + 256;
constexpr int C3_AT = 0, C3_RT = 2048, C3_BT = 4096, C3_KT = 6144, C3_BCT = 8192, C3_KCT = 10240, C3_VT = 12288, C3_CC = 13312;
constexpr int C3_GRAM = C3_IMG + 2 * C3_IMGSZ, C3_GRAMSZ = 2560;
constexpr int C3_MBQ = 0, C3_MKT = 1024, C3_NKT = 1536, C3_NBT = 2048;
constexpr int C3_G0 = C3_GRAM + 2 * C3_GRAMSZ, C3_SA = C3_G0 + 2048, C3_Y = C3_SA + 1024, C3_CNT = C3_Y + 2 * 1024, C3_END = C3_CNT + 16;
static_assert(C3_END <= LDS_BYTES, "chunked scan LDS");
DEVNI void bk_rwkv_chunk3(const Params& p, unsigned char* lds) {
    const int tid = TIDX, lane = tid & 63, wave = tid >> 6, fr = lane & 15, g = lane >> 4;
    constexpr int NCHK = SQ / 16;
    for (int it0 = blockIdx.x; it0 < NB * 8 * 2 * 2; it0 += gridDim.x) {
        const int it = (gridDim.x % 16 == 0) ? (((it0 & 7) + 8 * (it0 >> 4)) * 2 + ((it0 >> 3) & 1)) : it0;
        const int half = it & 1, dir = (it >> 1) & 1, h = (it >> 2) & 7, b = it >> 5; const int vt = half;
        const bf16_t* arr[6] = {p.fkk(), p.fr(), dir ? p.fomw1() : p.fomw0(), dir ? p.fkka1() : p.fkka0(), dir ? p.fkt1() : p.fkt0(), p.fv()};
        bf16_t* yout = (dir ? p.ybw() : p.yf()) + h * 64 + half * 32;
        f32x4 X[2][4];
#pragma unroll
        for (int u = 0; u < 2; ++u)
#pragma unroll
            for (int j = 0; j < 4; ++j) X[u][j] = (f32x4){0.f, 0.f, 0.f, 0.f};
        u32x4 grA[3], grB[3];
#define C3_GLOAD(ch, gr) { _Pragma("unroll") for (int i = 0; i < 3; ++i) { const int c_ = tid + 256 * i, a_ = c_ >> 7, st_ = (c_ & 127) >> 3, c8_ = c_ & 7; \
            gr[i] = *(const u32x4*)(arr[a_] + (size_t)scan_tok(b, dir, (ch) * 16 + st_) * 512 + h * 64 + c8_ * 8); } }
#define C3_LSTORE(bf, gr) { _Pragma("unroll") for (int i = 0; i < 3; ++i) { const int c_ = tid + 256 * i; *(u32x4*)(lds + C3_RAW + (bf) * 12288 + c_ * 16) = gr[i]; } }
#define C3_PREP(ch, ib) if (wave > 0) { const bf16_t* raw = (const bf16_t*)(lds + C3_RAW + ((ch) & 1) * 12288); unsigned char* im = lds + C3_IMG + (ib) * C3_IMGSZ; const int k = lane; \
            float wv[16], xa[16], xb[16]; \
            _Pragma("unroll") for (int t = 0; t < 16; ++t) { wv[t] = 1.0f - bf2f(raw[(2 * 16 + t) * 64 + k]); xa[t] = bf2f(raw[((wave == 1 ? 0 : wave == 2 ? 3 : 4) * 16 + t) * 64 + k]); xb[t] = (wave == 1) ? bf2f(raw[(1 * 16 + t) * 64 + k]) : 0.f; } \
            float c = 1.f, cc[17]; cc[0] = 1.f; \
            _Pragma("unroll") for (int t = 0; t < 16; ++t) { c *= wv[t]; cc[t + 1] = c; } \
            if (wave == 1) { _Pragma("unroll") for (int t = 0; t < 16; ++t) { *(bf16_t*)(im + C3_AT + (t * 64 + k) * 2) = f2bf(xa[t] * cc[t]); *(bf16_t*)(im + C3_RT + (t * 64 + k) * 2) = f2bf(xb[t] * cc[t + 1]); } \
                *(float*)(im + C3_CC + k * 4) = c; } \
            else { float sc[16]; float suf = 1.0f; const float rc16 = FAST_RCP(c);            \
                _Pragma("unroll") for (int t = 15; t >= 0; --t) { sc[t] = xa[t] * suf; *(bf16_t*)(im + (wave == 2 ? C3_BT : C3_KT) + (t * 64 + k) * 2) = f2bf(sc[t] * rc16); suf *= wv[t]; } \
                u32x4 w0, w1; w0.x = pack2bf(sc[0], sc[1]); w0.y = pack2bf(sc[2], sc[3]); w0.z = pack2bf(sc[4], sc[5]); w0.w = pack2bf(sc[6], sc[7]); \
                w1.x = pack2bf(sc[8], sc[9]); w1.y = pack2bf(sc[10], sc[11]); w1.z = pack2bf(sc[12], sc[13]); w1.w = pack2bf(sc[14], sc[15]); \
                *(u32x4*)(im + (wave == 2 ? C3_BCT : C3_KCT) + k * 32) = w0; *(u32x4*)(im + (wave == 2 ? C3_BCT : C3_KCT) + k * 32 + 16) = w1; \
                if (wave == 3 && lane < 32) { bf16_t vv[16]; _Pragma("unroll") for (int t = 0; t < 16; ++t) vv[t] = raw[(5 * 16 + t) * 64 + vt * 32 + lane]; \
                    u32x4 v0, v1; v0.x = vv[0] | ((unsigned)vv[1] << 16); v0.y = vv[2] | ((unsigned)vv[3] << 16); v0.z = vv[4] | ((unsigned)vv[5] << 16); v0.w = vv[6] | ((unsigned)vv[7] << 16); \
                    v1.x = vv[8] | ((unsigned)vv[9] << 16); v1.y = vv[10] | ((unsigned)vv[11] << 16); v1.z = vv[12] | ((unsigned)vv[13] << 16); v1.w = vv[14] | ((unsigned)vv[15] << 16); \
                    *(u32x4*)(im + C3_VT + lane * 32) = v0; *(u32x4*)(im + C3_VT + lane * 32 + 16) = v1; } } }
#define C3_GRAM1(ib, AI, BI, KIND) { const unsigned char* im = lds + C3_IMG + (ib) * C3_IMGSZ; unsigned char* gm = lds + C3_GRAM + (ib) * C3_GRAMSZ; f32x4 d = (f32x4){0.f, 0.f, 0.f, 0.f}; \
            _Pragma("unroll") for (int ks = 0; ks < 2; ++ks) d = MFMA16(*(const bf16x8*)(im + (AI) + fr * 128 + (32 * ks + 8 * g) * 2), *(const bf16x8*)(im + (BI) + fr * 128 + (32 * ks + 8 * g) * 2), d); \
            _Pragma("unroll") for (int r = 0; r < 4; ++r) { const int t = 4 * g + r, i = fr; const bool keep = ((KIND) < 2) ? (i < t) : (i <= t); const float val = keep ? d[r] : 0.f; \
                if ((KIND) == 0) *(float*)(gm + C3_MBQ + ((t * 4 + (i & 3)) * 4 + (i >> 2)) * 4) = val; \
                else *(bf16_t*)(gm + ((KIND) == 1 ? C3_MKT : (KIND) == 2 ? C3_NBT : C3_NKT) + (t * 16 + i) * 2) = f2bf(val); } }
#define C3_GRAMS(ib) { if (wave == 1) C3_GRAM1(ib, C3_AT, C3_BT, 0) else if (wave == 2) { C3_GRAM1(ib, C3_AT, C3_KT, 1) C3_GRAM1(ib, C3_RT, C3_BT, 2) } else if (wave == 3) C3_GRAM1(ib, C3_RT, C3_KT, 3) }
        auto c2_body = [&](const int ch, const int ib) {
            if (wave == 0 && (0 == 3 || 0 == 4)) { }
            else if (wave == 0) {
                const unsigned char* im = lds + C3_IMG + ib * C3_IMGSZ; const unsigned char* gm = lds + C3_GRAM + ib * C3_GRAMSZ;
                if (ch > 0) { const int t_ = lane >> 2, qd = lane & 3;
                    *(u32x4*)(yout + (size_t)scan_tok(b, dir, (ch - 1) * 16 + t_) * 512 + qd * 8) = *(const u32x4*)(lds + C3_Y + ((ch - 1) & 1) * 1024 + t_ * 64 + qd * 16); }
                bf16x8 sb[2][2], vb[2];
#pragma unroll
                for (int u = 0; u < 2; ++u) {
#pragma unroll
                    for (int m = 0; m < 2; ++m) { u32x4 w; w.x = pack2bf(X[u][2 * m][0], X[u][2 * m][1]); w.y = pack2bf(X[u][2 * m][2], X[u][2 * m][3]); w.z = pack2bf(X[u][2 * m + 1][0], X[u][2 * m + 1][1]); w.w = pack2bf(X[u][2 * m + 1][2], X[u][2 * m + 1][3]); sb[u][m] = __builtin_bit_cast(bf16x8, w); }
                    vb[u] = ck_frag16(im + C3_VT, 16 * u + fr, g); }
                const bf16x8 a0 = ck_frag_perm(im + C3_AT, fr, 0, g), a1 = ck_frag_perm(im + C3_AT, fr, 1, g), r0 = ck_frag_perm(im + C3_RT, fr, 0, g), r1 = ck_frag_perm(im + C3_RT, fr, 1, g);
                const bf16x8 mk = ck_frag16(gm + C3_MKT, fr, g), nk = ck_frag16(gm + C3_NKT, fr, g), nb = ck_frag16(gm + C3_NBT, fr, g);
                bf16x8 kcf[4]; f32x4 ccv[4];
#pragma unroll
                for (int j = 0; j < 4; ++j) { kcf[j] = ck_frag16(im + C3_KCT, 16 * j + fr, g); ccv[j] = *(const f32x4*)(im + C3_CC + (16 * j + 4 * g) * 4); }
                const int q = lane & 3, vv = lane >> 2;
                f32x4 y[2];
#pragma unroll
                for (int u = 0; u < 2; ++u) {
                    f32x4 d = (f32x4){0.f, 0.f, 0.f, 0.f}; d = MFMA16(a0, sb[u][0], d); d = MFMA16(a1, sb[u][1], d); d = MFMA16(mk, vb[u], d);
                    y[u] = (f32x4){0.f, 0.f, 0.f, 0.f}; y[u] = MFMA16(r0, sb[u][0], y[u]); y[u] = MFMA16(r1, sb[u][1], y[u]); y[u] = MFMA16(nk, vb[u], y[u]);
#pragma unroll
                    for (int j = 0; j < 4; ++j) X[u][j] = MFMA16(kcf[j], vb[u], X[u][j] * ccv[j]);
                    *(f32x4*)(lds + C3_G0 + ((16 * u + fr) * 16 + 4 * g) * 4) = d; }
                WAVE_SYNC()
                f32x4 mbv[16];
#pragma unroll
                for (int t = 0; t < 16; ++t) mbv[t] = *(const f32x4*)(gm + C3_MBQ + (t * 4 + q) * 16);
                f32x4 g0v[2][4];
#pragma unroll
                for (int u = 0; u < 2; ++u)
#pragma unroll
                    for (int m = 0; m < 4; ++m) g0v[u][m] = *(const f32x4*)(lds + C3_G0 + ((16 * u + vv) * 16 + 4 * m) * 4);
                float sq[2][4] = {{0.f, 0.f, 0.f, 0.f}, {0.f, 0.f, 0.f, 0.f}};
#pragma unroll
                for (int t = 0; t < 16; ++t) {
                    float pa = (sq[0][0] * mbv[t][0] + sq[0][1] * mbv[t][1]) + (sq[0][2] * mbv[t][2] + sq[0][3] * mbv[t][3]);
                    float pb = (sq[1][0] * mbv[t][0] + sq[1][1] * mbv[t][1]) + (sq[1][2] * mbv[t][2] + sq[1][3] * mbv[t][3]);
                    pa += QUAD_XOR1(pa); pb += QUAD_XOR1(pb); pa += QUAD_XOR2(pa); pb += QUAD_XOR2(pb);
                    const float va = g0v[0][t >> 2][t & 3] - pa, vb2 = g0v[1][t >> 2][t & 3] - pb; if (q == (t & 3)) { sq[0][t >> 2] = va; sq[1][t >> 2] = vb2; } }
#pragma unroll
                for (int u = 0; u < 2; ++u)
#pragma unroll
                    for (int m = 0; m < 4; ++m) *(bf16_t*)(lds + C3_SA + ((16 * u + vv) * 16 + 4 * m + q) * 2) = f2bf(-sq[u][m]);
                WAVE_SYNC()
                bf16x8 bcf[4];
#pragma unroll
                for (int j = 0; j < 4; ++j) bcf[j] = ck_frag16(im + C3_BCT, 16 * j + fr, g);
#pragma unroll
                for (int u = 0; u < 2; ++u) { const bf16x8 nsa = ck_frag16(lds + C3_SA, 16 * u + fr, g);
                    y[u] = MFMA16(nb, nsa, y[u]);
#pragma unroll
                    for (int j = 0; j < 4; ++j) X[u][j] = MFMA16(bcf[j], nsa, X[u][j]);
#pragma unroll
                    for (int r = 0; r < 4; ++r) *(bf16_t*)(lds + C3_Y + ib * 1024 + ((4 * g + r) * 32 + 16 * u + fr) * 2) = f2bf(y[u][r]); }
            } else {
                if (ch + 1 < NCHK && 0 != 1 && 0 != 4) C3_PREP(ch + 1, ib ^ 1)
                {
                  volatile int* cnt = (volatile int*)(lds + C3_CNT); WAVE_SYNC()
                  if (lane == 0) atomicAdd((int*)(lds + C3_CNT), 1);
                  const int want = 3 * (ch + 2); while (*cnt < want) SPIN_PAUSE();
                  WAVE_SYNC() }
                if (ch + 1 < NCHK && 0 != 1 && 0 != 4) C3_GRAMS(ib ^ 1)
            }
        };
#define C3_BODY(ch, ib) c2_body(ch, ib);
        static_assert(NCHK % 2 == 0 && NCHK >= 4, "chunk pairs");
        __syncthreads();
        C3_GLOAD(0, grA) C3_LSTORE(0, grA)
        C3_GLOAD(1, grB) C3_GLOAD(2, grA)
        if (tid == 0) *(int*)(lds + C3_CNT) = 3;
        __syncthreads();
        C3_PREP(0, 0)
        C3_LSTORE(1, grB)
        __syncthreads();
        C3_GRAMS(0)
        __syncthreads();
#define C3_ITER(ch, GR_LOAD, GR_STORE) { \
            const int ib = (ch) & 1; \
            if ((ch) + 3 < NCHK) C3_GLOAD((ch) + 3, GR_LOAD) \
            C3_BODY(ch, ib) \
            if ((ch) + 2 < NCHK) C3_LSTORE((ch) & 1, GR_STORE) \
            __syncthreads(); }
        for (int ch = 0; ch < NCHK; ch += 2) {
            C3_ITER(ch, grB, grA)
            C3_ITER(ch + 1, grA, grB)
        }
#undef C3_ITER
        if (wave == 0) { const int t_ = lane >> 2, qd = lane & 3;
            *(u32x4*)(yout + (size_t)scan_tok(b, dir, (NCHK - 1) * 16 + t_) * 512 + qd * 8) = *(const u32x4*)(lds + C3_Y + ((NCHK - 1) & 1) * 1024 + t_ * 64 + qd * 16); }
#undef C3_GLOAD
#undef C3_LSTORE
#undef C3_PREP
#undef C3_GRAM1
#undef C3_GRAMS
#undef C3_BODY
    }
}


DEVFN void unpack8(const u32x4 w, float* f) {
    f[0] = __builtin_bit_cast(float, w.x << 16); f[1] = __builtin_bit_cast(float, w.x & 0xffff0000u); f[2] = __builtin_bit_cast(float, w.y << 16); f[3] = __builtin_bit_cast(float, w.y & 0xffff0000u);
    f[4] = __builtin_bit_cast(float, w.z << 16); f[5] = __builtin_bit_cast(float, w.z & 0xffff0000u); f[6] = __builtin_bit_cast(float, w.w << 16); f[7] = __builtin_bit_cast(float, w.w & 0xffff0000u);
}
DEVFN u32x4 pack8(const float* f) { u32x4 w; w.x = pack2bf(f[0], f[1]); w.y = pack2bf(f[2], f[3]); w.z = pack2bf(f[4], f[5]); w.w = pack2bf(f[6], f[7]); return w; }

DEVNI void bk_mod(const Params& p, unsigned char* lds, int l0 = 0, int l1 = 2, int b0 = 0) {
    float* sl = (float*)lds;
    const int tid = TIDX, cl = tid & 63, kg = tid >> 6;
    __syncthreads();
    if ((int)blockIdx.x < b0) return;
    for (int i = tid; i < (NB + 1) * D; i += 256) { const int r = i / D, k = i % D; sl[i] = siluf_(r < NB ? p.c[r * D + k] : p.c_ctx[k]); }
    __syncthreads();
    float* part = sl + (NB + 1) * D;
    for (int it = l0 * (NMOD / 64) + (int)blockIdx.x - b0; it < l1 * (NMOD / 64); it += gridDim.x - b0) {
        const int l = it / (NMOD / 64), n = (it % (NMOD / 64)) * 64 + cl;
        float acc[NB + 1];
#pragma unroll
        for (int r = 0; r <= NB; ++r) acc[r] = 0.f;
        const float* wp = p.ada_w + ((size_t)l * D + kg * 256) * NMOD + n;
#pragma unroll 4
        for (int k = 0; k < 256; k += 4) { const float w0 = wp[(size_t)k * NMOD], w1 = wp[(size_t)(k + 1) * NMOD], w2 = wp[(size_t)(k + 2) * NMOD], w3 = wp[(size_t)(k + 3) * NMOD];
#pragma unroll
            for (int r = 0; r <= NB; ++r) { const f32x4 sv = *(const f32x4*)(sl + r * D + kg * 256 + k); acc[r] += (sv[0] * w0 + sv[1] * w1) + (sv[2] * w2 + sv[3] * w3); } }
        __syncthreads();
#pragma unroll
        for (int r = 0; r <= NB; ++r) part[(kg * (NB + 1) + r) * 64 + cl] = acc[r];
        __syncthreads();
        for (int i = tid; i < (NB + 1) * 64; i += 256) { const int r = i / 64, c = i % 64;
            p.mod()[((size_t)l * (NB + 1) + r) * NMOD + (it % (NMOD / 64)) * 64 + c] = p.ada_b[(size_t)l * NMOD + (it % (NMOD / 64)) * 64 + c] + (part[(0 * (NB + 1) + r) * 64 + c] + part[(1 * (NB + 1) + r) * 64 + c]) + (part[(2 * (NB + 1) + r) * 64 + c] + part[(3 * (NB + 1) + r) * 64 + c]); }
    }
    if (l0 != 0) return;
    for (int i = blockIdx.x * 256 + tid; i < 2 * 48 * D; i += gridDim.x * 256) { const int l = i / (48 * D), n = (i / D) % 48, k = i % D;
        const float w = n < 4 ? p.moe_w_grp[((size_t)l * D + k) * 4 + n] : n < 36 ? p.moe_w_exp[((size_t)l * D + k) * 32 + (n - 4)] : 0.f;
        const bf16_t hi = f2bf(w); p.wr_hi()[i] = hi; p.wr_lo()[i] = f2bf(w - bf2f(hi)); }
    for (int i = blockIdx.x * 256 + tid; i < 64; i += gridDim.x * 256) p.mcnt()[i] = 0;
    for (int i = blockIdx.x * 256 + tid; i < 1024; i += gridDim.x * 256) { const float ang = (float)(i / 16) * powf(10000.0f, -(float)(i % 16) / 16.0f); p.ropetab()[2 * i] = cosf(ang); p.ropetab()[2 * i + 1] = sinf(ang); }
}

DEVNI void bk_norm(const Params& p, int layer, int which, int t0, bool dry = false) {
    const int tid = TIDX, lane = tid & 63, wave = tid >> 6, sub = lane >> 4, kq = lane & 15;
    const int ntok = T - t0, ngrp = (ntok + 15) / 16;
    for (int it = blockIdx.x; it < ngrp; it += gridDim.x) {
        const int tk = t0 + it * 16 + wave * 4 + sub;
        const bool fromin = (layer == 0 && which == 1); const float* hf = hin(p, tk); bf16_t* hbr = hrow(p, tk);
        const bool addys = (layer == 1 && which == 1) || which == 3;
        float ss = 0.f;
#pragma unroll
        for (int i = 0; i < 16; ++i) { const int k = 64 * i + 4 * kq; f32x4 x = fromin ? *(const f32x4*)(hf + k) : ld4bf(hbr + k);
            if (addys) { const u32x2 a = *(const u32x2*)(p.ys() + (size_t)(tk * 2) * D + k), b2 = *(const u32x2*)(p.ys() + (size_t)(tk * 2 + 1) * D + k);
                x[0] += __builtin_bit_cast(float, a.x << 16) + __builtin_bit_cast(float, b2.x << 16); x[1] += __builtin_bit_cast(float, a.x & 0xffff0000u) + __builtin_bit_cast(float, b2.x & 0xffff0000u);
                x[2] += __builtin_bit_cast(float, a.y << 16) + __builtin_bit_cast(float, b2.y << 16); x[3] += __builtin_bit_cast(float, a.y & 0xffff0000u) + __builtin_bit_cast(float, b2.y & 0xffff0000u);
                *(u32x2*)(hbr + k) = pack4bf(x); }
            ss += (x[0] * x[0] + x[1] * x[1]) + (x[2] * x[2] + x[3] * x[3]); }
        RED16(ss)
        const float rstd = rsqrtf(ss / D + EPS);
        if (which == 3) {
#pragma unroll
            for (int i = 0; i < 16; ++i) { const int k = 64 * i + 4 * kq; const f32x4 x = ld4bf(hbr + k), g = *(const f32x4*)(p.final_g + k); *(f32x4*)(p.out + (size_t)(tk - TC) * D + k) = x * rstd * g; }
            continue;
        }
        const float* gain = (which == 1 ? p.norm1_g : p.norm2_g) + (size_t)layer * D;
        const int mr = modrow(tk); const float* sh = modp(p, layer, mr, which == 1 ? 0 : 3); const float* sc = modp(p, layer, mr, which == 1 ? 1 : 4);
        if (which == 1) {
#pragma unroll
            for (int i = 0; i < 16; ++i) { const int k = 64 * i + 4 * kq; const f32x4 x = fromin ? *(const f32x4*)(hf + k) : ld4bf(hbr + k), g = *(const f32x4*)(gain + k), s1 = *(const f32x4*)(sc + k), s0 = *(const f32x4*)(sh + k);
                *(u32x2*)(p.xn() + (size_t)tk * D + k) = pack4bf((x * rstd * g) * (s1 + 1.0f) + s0); }
            continue;
        }
        float lg[4], le[32];
#pragma unroll
        for (int j = 0; j < 4; ++j) lg[j] = 0.f;
#pragma unroll
        for (int j = 0; j < 32; ++j) le[j] = 0.f;
        const float* wg = p.moe_w_grp + (size_t)layer * D * 4; const float* we = p.moe_w_exp + (size_t)layer * D * 32;
#pragma unroll 1
        for (int i = 0; i < 16; ++i) { const int k0 = 64 * i + 4 * kq; const f32x4 x = ld4bf(hbr + k0), g = *(const f32x4*)(gain + k0), s1 = *(const f32x4*)(sc + k0), s0 = *(const f32x4*)(sh + k0);
            const f32x4 xv = (x * rstd * g) * (s1 + 1.0f) + s0; *(u32x2*)(p.xn() + (size_t)tk * D + k0) = pack4bf(xv);
#pragma unroll
            for (int e = 0; e < 4; ++e) { const int k = k0 + e; const float v = xv[e]; const f32x4 g4 = *(const f32x4*)(wg + k * 4);
#pragma unroll
                for (int j = 0; j < 4; ++j) lg[j] += v * g4[j];
#pragma unroll
                for (int q = 0; q < 8; ++q) { const f32x4 e4 = *(const f32x4*)(we + k * 32 + q * 4);
#pragma unroll
                    for (int j = 0; j < 4; ++j) le[q * 4 + j] += v * e4[j]; } } }
#pragma unroll
        for (int j = 0; j < 4; ++j) { RED16(lg[j]) lg[j] += p.moe_b_grp[layer * 4 + j]; }
#pragma unroll
        for (int j = 0; j < 32; ++j) { RED16(le[j]) le[j] += p.moe_b_exp[layer * 32 + j]; }
        if (kq == 0 && !(dry && lg[0] != 12345.678f)) {
            int gi = 0; float gm = lg[0];
#pragma unroll
            for (int j = 1; j < 4; ++j) if (lg[j] > gm) { gm = lg[j]; gi = j; }
            float gz = 0.f;
#pragma unroll
            for (int j = 0; j < 4; ++j) gz += expf(lg[j] - gm);
            const float pg = 1.0f / gz;
            float es[8];
#pragma unroll
            for (int j = 0; j < 8; ++j) es[j] = gi == 0 ? le[j] : gi == 1 ? le[8 + j] : gi == 2 ? le[16 + j] : le[24 + j];
            int i1 = 0; float e1 = es[0];
#pragma unroll
            for (int j = 1; j < 8; ++j) if (es[j] > e1) { e1 = es[j]; i1 = j; }
            int i2 = -1; float e2 = -3.0e38f;
#pragma unroll
            for (int j = 0; j < 8; ++j) if (j != i1 && es[j] > e2) { e2 = es[j]; i2 = j; }
            const float r = expf(e2 - e1), inv = 1.0f / (1.0f + r);
            const int ea = gi * 8 + i1, eb = gi * 8 + i2;
            p.eidx()[tk * 2 + 0] = ea; p.eidx()[tk * 2 + 1] = eb; p.ew()[tk * 2 + 0] = pg * inv; p.ew()[tk * 2 + 1] = pg * r * inv;
            const int pa = atomicAdd(p.mcnt() + layer * 32 + ea, 1); p.mlist()[(size_t)ea * (T * 2) + pa] = tk * 2;
            const int pb = atomicAdd(p.mcnt() + layer * 32 + eb, 1); p.mlist()[(size_t)eb * (T * 2) + pb] = tk * 2 + 1;
        }
    }
}

DEVNI void bk_norm_router(const Params& p, unsigned char* lds, int layer, int t0, bool dry) {
    const int tid = TIDX, lane = tid & 63, wave = tid >> 6, tl = lane & 15, kc = lane >> 4;
    const float* gain = p.norm2_g + (size_t)layer * D; float* lg = (float*)lds + wave * 16 * 48;
    const bf16_t* whi = p.wr_hi() + (size_t)layer * 48 * D; const bf16_t* wlo = p.wr_lo() + (size_t)layer * 48 * D;
    for (int wi = blockIdx.x * 4 + wave; wi < (T - t0) / 16; wi += gridDim.x * 4) {
        const int tk = t0 + wi * 16 + tl; const bf16_t* h = hrow(p, tk);
        float ss = 0.f;
#pragma unroll 16
        for (int ks = 0; ks < 32; ++ks) { float hv[8]; unpack8(*(const u32x4*)(h + 32 * ks + 8 * kc), hv); const f32x4 a = (f32x4){hv[0], hv[1], hv[2], hv[3]}, b2 = (f32x4){hv[4], hv[5], hv[6], hv[7]};
            ss += ((a[0] * a[0] + a[1] * a[1]) + (a[2] * a[2] + a[3] * a[3])) + ((b2[0] * b2[0] + b2[1] * b2[1]) + (b2[2] * b2[2] + b2[3] * b2[3])); }
        ss += SHFL_XOR(ss, 16); ss += SHFL_XOR(ss, 32);
        const float rstd = rsqrtf(ss / D + EPS);
        const int mr = modrow(tk); const float* sh = modp(p, layer, mr, 3); const float* sc = modp(p, layer, mr, 4);
        f32x4 acc[3];
#pragma unroll
        for (int nt = 0; nt < 3; ++nt) acc[nt] = (f32x4){0.f, 0.f, 0.f, 0.f};
#pragma unroll 4
        for (int ks = 0; ks < 32; ++ks) { const int k = 32 * ks + 8 * kc; float xv[8], xl[8];
#pragma unroll
            for (int q = 0; q < 2; ++q) { const f32x4 x = ld4bf(h + k + 4 * q), g = *(const f32x4*)(gain + k + 4 * q), s1 = *(const f32x4*)(sc + k + 4 * q), s0 = *(const f32x4*)(sh + k + 4 * q);
                const f32x4 v = (x * rstd * g) * (s1 + 1.0f) + s0; xv[4 * q] = v[0]; xv[4 * q + 1] = v[1]; xv[4 * q + 2] = v[2]; xv[4 * q + 3] = v[3]; }
            const u32x4 hw = pack8(xv); *(u32x4*)(p.xn() + (size_t)tk * D + k) = hw;
            float xh[8]; unpack8(hw, xh);
#pragma unroll
            for (int e = 0; e < 8; ++e) xl[e] = xv[e] - xh[e];
            const bf16x8 ahi = __builtin_bit_cast(bf16x8, hw), alo = __builtin_bit_cast(bf16x8, pack8(xl));
#pragma unroll
            for (int nt = 0; nt < 3; ++nt) { const bf16x8 bhi = *(const bf16x8*)(whi + (size_t)(nt * 16 + tl) * D + k), blo = *(const bf16x8*)(wlo + (size_t)(nt * 16 + tl) * D + k);
                acc[nt] = MFMA16(ahi, bhi, acc[nt]); acc[nt] = MFMA16(ahi, blo, acc[nt]); acc[nt] = MFMA16(alo, bhi, acc[nt]); }
        }
        WAVE_SYNC()
#pragma unroll
        for (int nt = 0; nt < 3; ++nt)
#pragma unroll
            for (int r = 0; r < 4; ++r) lg[(kc * 4 + r) * 48 + nt * 16 + tl] = acc[nt][r];
        WAVE_SYNC()
        if (lane < 16) {
            const float* my = lg + lane * 48; float l4[4], le[32];
#pragma unroll
            for (int j = 0; j < 4; ++j) l4[j] = my[j] + p.moe_b_grp[layer * 4 + j];
            int gi = 0; float gm = l4[0];
#pragma unroll
            for (int j = 1; j < 4; ++j) if (l4[j] > gm) { gm = l4[j]; gi = j; }
            float gz = 0.f;
#pragma unroll
            for (int j = 0; j < 4; ++j) gz += expf(l4[j] - gm);
            const float pg = 1.0f / gz;
            float es[8];
#pragma unroll
            for (int j = 0; j < 8; ++j) es[j] = my[4 + gi * 8 + j] + p.moe_b_exp[layer * 32 + gi * 8 + j];
            int i1 = 0; float e1 = es[0];
#pragma unroll
            for (int j = 1; j < 8; ++j) if (es[j] > e1) { e1 = es[j]; i1 = j; }
            int i2 = -1; float e2 = -3.0e38f;
#pragma unroll
            for (int j = 0; j < 8; ++j) if (j != i1 && es[j] > e2) { e2 = es[j]; i2 = j; }
            const float r = expf(e2 - e1), inv = 1.0f / (1.0f + r);
            const int ea = gi * 8 + i1, eb = gi * 8 + i2; (void)le;
            if (!(dry && gm != 12345.678f)) {
                p.eidx()[tk * 2 + 0] = ea; p.eidx()[tk * 2 + 1] = eb; p.ew()[tk * 2 + 0] = pg * inv; p.ew()[tk * 2 + 1] = pg * r * inv;
                const int pa = atomicAdd(p.mcnt() + layer * 32 + ea, 1); p.mlist()[(size_t)ea * (T * 2) + pa] = tk * 2;
                const int pb = atomicAdd(p.mcnt() + layer * 32 + eb, 1); p.mlist()[(size_t)eb * (T * 2) + pb] = tk * 2 + 1;
            }
        }
    }
}

DEVNI void bk_feat1(const Params& p) {
    const int tid = TIDX, lane = tid & 63, wave = tid >> 6;
    for (int it = blockIdx.x; it < T / 4; it += gridDim.x) {
        const int tk = it * 4 + wave; int pos, len; if (tk < TC) { pos = tk % NC; len = NC; } else { pos = (tk - TC) % NL; len = NL; }
        const bool hasp = pos > 0, hasn = pos < len - 1;
#pragma unroll
        for (int i = 0; i < 4; ++i) {
            const int c8 = lane + 64 * i;
            if (c8 >= 244) { if (c8 < 248) *(u32x4*)(p.lin() + (size_t)tk * LIN_LD + (c8 - 192) * 8) = (u32x4){0u, 0u, 0u, 0u}; continue; }
            const int col = c8 * 8; float y[8], pv[8], nx[8], sv[8];
            unpack8(*(const u32x4*)(p.prw() + (size_t)tk * SHIFT_W + col), y);
            if (hasp) unpack8(*(const u32x4*)(p.prw() + (size_t)(tk - 1) * SHIFT_W + col), pv); else { for (int e = 0; e < 8; ++e) pv[e] = 0.f; }
            if (hasn) unpack8(*(const u32x4*)(p.prw() + (size_t)(tk + 1) * SHIFT_W + col), nx); else { for (int e = 0; e < 8; ++e) nx[e] = 0.f; }
#pragma unroll
            for (int e = 0; e < 8; ++e) sv[e] = y[e] + p.ev_shift_mu[col + e] * (pv[e] - y[e]) + p.ev_shift_mu[SHIFT_W + col + e] * (nx[e] - y[e]);
            if (i == 0) *(u32x4*)(p.fr() + (size_t)tk * 512 + col) = pack8(sv);
            else if (i == 1) { const int c = col - 512; float n2 = 0.f;
#pragma unroll
                for (int e = 0; e < 8; ++e) { sv[e] *= p.rwkv_k_k[c + e]; n2 += sv[e] * sv[e]; }
                RED8(n2)
                const float nrm = fmaxf(sqrtf(n2), 1e-12f), inv = 1.0f / nrm;
#pragma unroll
                for (int e = 0; e < 8; ++e) sv[e] *= inv;
                *(u32x4*)(p.fkk() + (size_t)tk * 512 + c) = pack8(sv);
                if ((lane & 7) == 0) p.fnrm()[(size_t)tk * 8 + (c >> 6)] = nrm; }
            else if (i == 2) *(u32x4*)(p.fv() + (size_t)tk * 512 + (col - 1024)) = pack8(sv);
            else { const int j8 = c8 - 192;
#pragma unroll
                for (int e = 0; e < 8; ++e) sv[e] = j8 < 16 ? (2.0f * fast_sigmoid(2.0f * sv[e]) - 1.0f) : j8 < 32 ? sv[e] : fast_sigmoid(sv[e]);
                *(u32x4*)(p.lin() + (size_t)tk * LIN_LD + j8 * 8) = pack8(sv); }
        }
    }
}
DEVNI void bk_feat2(const Params& p, unsigned char* lds) {
    constexpr int NTM = T / GBM;
    for (int it = blockIdx.x; it < 5 * NTM * 4; it += gridDim.x) {
        const int g = it / (NTM * 4), mt = it % NTM, nt = (it / NTM) % 4;
        if (g < 2) {
            bf16_t* omw = g ? p.fomw1() : p.fomw0();
            gemm_tile<true>(lds, plainA(p.lin() + g * 64, LIN_LD), mt * GBM, p.wt_w2() + (size_t)g * 512 * 64, 64, nt * GBN, 64, [&](f32x4 (&acc)[4][4], int mb, int nb, int fr, int fq) {
#pragma unroll
                for (int mi = 0; mi < 4; ++mi)
#pragma unroll
                    for (int ni = 0; ni < 4; ++ni) { const int row = mb + mi * 16 + fr, col = nb + ni * 16 + fq * 4; f32x4 v;
#pragma unroll
                        for (int r = 0; r < 4; ++r) { const float sg = fast_sigmoid(p.rwkv_w0[g * 512 + col + r] + acc[mi][ni][r]);
                            v[r] = 1.0f - FAST_EXP2(-0.8750612633917001f * sg); }
                        *(u32x2*)(omw + (size_t)row * 512 + col) = pack4bf(v); }
            });
        } else if (g < 4) {
            const int d = g - 2; bf16_t* kka = d ? p.fkka1() : p.fkka0(); bf16_t* kt = d ? p.fkt1() : p.fkt0();
            gemm_tile<true>(lds, plainA(p.lin() + 128 + d * 64, LIN_LD), mt * GBM, p.wt_a2() + (size_t)d * 512 * 64, 64, nt * GBN, 64, [&](f32x4 (&acc)[4][4], int mb, int nb, int fr, int fq) {
#pragma unroll
                for (int mi = 0; mi < 4; ++mi)
#pragma unroll
                    for (int ni = 0; ni < 4; ++ni) { const int row = mb + mi * 16 + fr, col = nb + ni * 16 + fq * 4; const u32x2 kw = *(const u32x2*)(p.fkk() + (size_t)row * 512 + col);
                        const float kkv[4] = {__builtin_bit_cast(float, kw.x << 16), __builtin_bit_cast(float, kw.x & 0xffff0000u), __builtin_bit_cast(float, kw.y << 16), __builtin_bit_cast(float, kw.y & 0xffff0000u)};
                        const float nrm = p.fnrm()[(size_t)row * 8 + (col >> 6)]; f32x4 va, vt;
#pragma unroll
                        for (int r = 0; r < 4; ++r) { const float a = fast_sigmoid(p.rwkv_a0[d * 512 + col + r] + acc[mi][ni][r]); va[r] = kkv[r] * a;
                            vt[r] = kkv[r] * (nrm / p.rwkv_k_k[col + r]) * (1.0f + (a - 1.0f) * p.rwkv_k_a[col + r]); }
                        *(u32x2*)(kka + (size_t)row * 512 + col) = pack4bf(va); *(u32x2*)(kt + (size_t)row * 512 + col) = pack4bf(vt); }
            });
        } else {
            gemm_tile<true>(lds, plainA(p.lin() + 256, LIN_LD), mt * GBM, p.wt_g2(), 192, nt * GBN, 192, [&](f32x4 (&acc)[4][4], int mb, int nb, int fr, int fq) {
#pragma unroll
                for (int mi = 0; mi < 4; ++mi)
#pragma unroll
                    for (int ni = 0; ni < 4; ++ni) { const int row = mb + mi * 16 + fr, col = nb + ni * 16 + fq * 4; *(u32x2*)(p.fgate() + (size_t)row * 512 + col) = pack4bf(acc[mi][ni]); }
            });
        }
    }
}
DEVNI void bk_mixout(const Params& p) {
    const int tid = TIDX, lane = tid & 63, wave = tid >> 6;
    for (int it = blockIdx.x; it < T / 4; it += gridDim.x) {
        const int tk = it * 4 + wave, c = lane * 8; const size_t o = (size_t)tk * 512 + c;
        float y[8], r[8], k0[8], k1[8], v[8], g[8];
        { float ya[8], yb2[8]; unpack8(*(const u32x4*)(p.yf() + o), ya); unpack8(*(const u32x4*)(p.ybw() + o), yb2);
#pragma unroll
          for (int e = 0; e < 8; ++e) y[e] = ya[e] + yb2[e]; }
        unpack8(*(const u32x4*)(p.fr() + o), r); unpack8(*(const u32x4*)(p.fkt0() + o), k0); unpack8(*(const u32x4*)(p.fkt1() + o), k1); unpack8(*(const u32x4*)(p.fv() + o), v); unpack8(*(const u32x4*)(p.fgate() + o), g);
        float mu = 0.f, bn = 0.f;
#pragma unroll
        for (int e = 0; e < 8; ++e) { mu += y[e]; bn += r[e] * (k0[e] + k1[e]) * p.rwkv_r_k[c + e]; }
        RED8(mu) RED8(bn)
        mu *= (1.0f / 64.f); float var = 0.f;
#pragma unroll
        for (int e = 0; e < 8; ++e) { const float d = y[e] - mu; var += d * d; }
        RED8(var)
        const float rs = rsqrtf(var * (1.0f / 64.f) + GN_EPS); float ov[8];
#pragma unroll
        for (int e = 0; e < 8; ++e) ov[e] = ((y[e] - mu) * rs * p.rwkv_lnx_w[c + e] + p.rwkv_lnx_b[c + e] + bn * v[e]) * g[e];
        *(u32x4*)(p.mixw() + o) = pack8(ov);
    }
}
DEVNI void bk_mlanorm(const Params& p) {
    const int tid = TIDX, lane = tid & 63, wave = tid >> 6;
    for (int it = blockIdx.x; it < T / 4; it += gridDim.x) {
        const int tk = it * 4 + wave; const bf16_t* a = p.qkva() + (size_t)tk * 704;
        const f32x4 q0 = ld4bf(a + 4 * lane); f32x4 q1 = (f32x4){0.f, 0.f, 0.f, 0.f}; if (lane < 32) q1 = ld4bf(a + 256 + 4 * lane);
        const f32x4 kv = ld4bf(a + 384 + 4 * lane);
        float s1 = (q0[0] * q0[0] + q0[1] * q0[1]) + (q0[2] * q0[2] + q0[3] * q0[3]) + (q1[0] * q1[0] + q1[1] * q1[1]) + (q1[2] * q1[2] + q1[3] * q1[3]);
        float s2 = (kv[0] * kv[0] + kv[1] * kv[1]) + (kv[2] * kv[2] + kv[3] * kv[3]);
        RED64(s1) RED64(s2)
        const float r1 = rsqrtf(s1 / 384.f + EPS), r2 = rsqrtf(s2 / 256.f + EPS);
        *(u32x2*)(p.cq() + (size_t)tk * 384 + 4 * lane) = pack4bf(q0 * r1 * *(const f32x4*)(p.mla_q_norm_g + 4 * lane));
        if (lane < 32) *(u32x2*)(p.cq() + (size_t)tk * 384 + 256 + 4 * lane) = pack4bf(q1 * r1 * *(const f32x4*)(p.mla_q_norm_g + 256 + 4 * lane));
        *(u32x2*)(p.ckv() + (size_t)tk * 256 + 4 * lane) = pack4bf(kv * r2 * *(const f32x4*)(p.mla_kv_norm_g + 4 * lane));
        f32x4 pe = (f32x4){0.f, 0.f, 0.f, 0.f}; if (lane < 16) pe = ld4bf(a + 640 + 4 * lane);
        f32x4 pr; pr[0] = SHFL_XOR(pe[0], 4); pr[1] = SHFL_XOR(pe[1], 4); pr[2] = SHFL_XOR(pe[2], 4); pr[3] = SHFL_XOR(pe[3], 4);
        if (lane < 16) {
            f32x4 o = pe;
            if (tk >= TC) { const int t = (tk - TC) % NL, hf = lane >> 3, pos = hf ? (t % 64) : (t / 64); const bool up = (lane & 4) != 0;
#pragma unroll
                for (int e = 0; e < 4; ++e) { const int i = (lane & 3) * 4 + e; const float cs = p.ropetab()[(pos * 16 + i) * 2], sn = p.ropetab()[(pos * 16 + i) * 2 + 1];
                    o[e] = up ? (pe[e] * cs + pr[e] * sn) : (pe[e] * cs - pr[e] * sn); } }
            *(u32x2*)(p.kpe() + (size_t)tk * 64 + 4 * lane) = pack4bf(o);
        }
    }
}


#ifndef HOST_EMU
#define XB_TMO      128
#define XB_XCNT(j)  (256  + 64 * (j))
#define XB_XSUB(j)  (1280 + 64 * (j))
#define XB_XGEN(j)  (2304 + 64 * (j))
#define XB_TOP      3328
#define XB_TOPGEN   3392
#define XCD_BAR_WORDS 3456
#define XB_SPIN_CAP (1u << 22)
#define LAS __attribute__((address_space(3)))
__device__ __forceinline__ unsigned xb_ld(unsigned* p)              { return __hip_atomic_load(p, __ATOMIC_RELAXED, __HIP_MEMORY_SCOPE_AGENT); }
__device__ __forceinline__ unsigned xb_add(unsigned* p, unsigned v) { return __hip_atomic_fetch_add(p, v, __ATOMIC_RELAXED, __HIP_MEMORY_SCOPE_AGENT); }
__device__ __forceinline__ unsigned xb_xcc_id() { return (unsigned)__builtin_amdgcn_s_getreg((3 << 11) | 20) & 0xFu; }
#define XB_SPIN(cond, bar) do { unsigned _sp = 0; while (cond) { __builtin_amdgcn_s_sleep(1); \
    if ((++_sp & 255u) == 0u) { if (xb_ld(&(bar)[XB_TMO])) break; if (_sp > XB_SPIN_CAP) { atomicAdd(&(bar)[XB_TMO], 1u); break; } } } } while (0)
struct XcdBarrier { unsigned* bar; unsigned x; volatile LAS unsigned* st; };
__device__ __forceinline__ XcdBarrier xcd_barrier_post(unsigned* bar, volatile LAS unsigned* st) {
    XcdBarrier b; b.bar = bar; b.x = xb_xcc_id(); b.st = st;
    if (threadIdx.x == 0) (void)xb_add(&bar[XB_XCNT(b.x)], 1u);
    return b;
}
__device__ __forceinline__ void xcd_barrier_complete(unsigned* bar, unsigned x, unsigned& nloc, unsigned& nx) {
    const unsigned G = gridDim.x * gridDim.y * gridDim.z;
    unsigned sum, cnt, mine, sp = 0u;
    for (;;) {
        sum = 0u; cnt = 0u; mine = 0u;
#pragma unroll
        for (unsigned j = 0; j < 16; ++j) { const unsigned c = xb_ld(&bar[XB_XCNT(j)]); sum += c; cnt += (c > 0u) ? 1u : 0u; mine = (j == x) ? c : mine; }
        if (sum == G) break;
        __builtin_amdgcn_s_sleep(1);
        if ((++sp & 255u) == 0u) { if (xb_ld(&bar[XB_TMO])) break; if (sp > XB_SPIN_CAP) { atomicAdd(&bar[XB_TMO], 1u); break; } }
    }
    nloc = mine > 0u ? mine : 1u; nx = cnt > 0u ? cnt : 1u;
}
__device__ __forceinline__ void xcd_barrier(const XcdBarrier& b) {
    asm volatile("s_waitcnt vmcnt(0)" ::: "memory");
    __syncthreads();
    if (threadIdx.x == 0) {
        unsigned* bar = b.bar;
        __builtin_amdgcn_s_waitcnt(0);
        unsigned nloc = b.st[0], nx = b.st[1];
        if (nloc == 0u) { xcd_barrier_complete(bar, b.x, nloc, nx); b.st[0] = nloc; b.st[1] = nx; }
        const unsigned old = xb_add(&bar[XB_XSUB(b.x)], 1u);
        const unsigned gen = old / nloc;
        if (old + 1u == (gen + 1u) * nloc) {
            __builtin_amdgcn_fence(__ATOMIC_RELEASE, "agent");
            asm volatile("s_waitcnt vmcnt(0)" ::: "memory");
            const unsigned og = xb_add(&bar[XB_TOP], 1u);
            const unsigned tg = og / nx;
            if (og + 1u == (tg + 1u) * nx) xb_add(&bar[XB_TOPGEN], 1u);
            else XB_SPIN(xb_ld(&bar[XB_TOPGEN]) == tg, bar);
            __builtin_amdgcn_fence(__ATOMIC_ACQUIRE, "agent");
            xb_add(&bar[XB_XGEN(b.x)], 1u);
            asm volatile("s_waitcnt vmcnt(0)" ::: "memory");
        } else {
            XB_SPIN(xb_ld(&bar[XB_XGEN(b.x)]) == gen, bar);
            __builtin_amdgcn_fence(__ATOMIC_ACQUIRE, "agent");
            asm volatile("s_waitcnt vmcnt(0)" ::: "memory");
        }
    }
    __syncthreads();
}
#endif

enum { BK_CONV_DENSE, BK_CONV_MOE, BK_EVIN, BK_WOUT, BK_WO, BK_MLAIN, BK_UQ, BK_UKV, BK_MOEH, BK_MOED, BK_UQROPE, BK_UKVS, BK_ATTN, BK_RETD, BK_RETP, BK_RETO, BK_RWKV, BK_MOD, BK_NORM01, BK_NORM02, BK_NORM11, BK_NORM12, BK_FINAL, BK_FEAT1, BK_FEAT2, BK_MIXOUT, BK_MLANORM, BK_NORM02D, BK_EMPTY, BK_RWKVQ, BK_RWKVP, BK_RWKVC, BK_UQ_UKV, BK_PROLOGUE, BK_RETD_FEAT1, BK_RWKV_CONV, BK_NORM11_CONV };
template <int PH> DEVFN void run_bphase(const Params& p, unsigned char* lds, int a0) {
    if constexpr (PH == BK_CONV_DENSE) bk_convert_dense(p, lds);
    else if constexpr (PH == BK_CONV_MOE) bk_convert_moe(p, lds, a0);
    else if constexpr (PH == BK_EVIN) bk_evin(p, lds);
    else if constexpr (PH == BK_WOUT) bk_wout(p, lds);
    else if constexpr (PH == BK_WO) bk_wo(p, lds);
    else if constexpr (PH == BK_MLAIN) bk_mlain(p, lds);
    else if constexpr (PH == BK_MOEH) bk_moe_hidden(p, lds, a0);
    else if constexpr (PH == BK_MOED) bk_moe_down(p, lds, a0);
    else if constexpr (PH == BK_UQROPE) bk_uq_rope(p, lds);
    else if constexpr (PH == BK_UKVS) bk_ukv_split(p, lds);
    else if constexpr (PH == BK_ATTN) bk_attn(p, lds);
    else if constexpr (PH == BK_RETD) bk_ret_delta(p, lds);
    else if constexpr (PH == BK_RETP) bk_ret_prefix(p, lds);
    else if constexpr (PH == BK_RETO) bk_ret_out(p, lds);
    else if constexpr (PH == BK_RWKV) bk_rwkv_scan(p, lds);
    else if constexpr (PH == BK_MOD) bk_mod(p, lds);
    else if constexpr (PH == BK_NORM01) bk_norm(p, 0, 1, 0);
    else if constexpr (PH == BK_NORM02) bk_norm_router(p, lds, 0, 0, false);
    else if constexpr (PH == BK_NORM11) bk_norm(p, 1, 1, 0);
    else if constexpr (PH == BK_NORM12) bk_norm_router(p, lds, 1, TC, false);
    else if constexpr (PH == BK_FINAL) bk_norm(p, 1, 3, TC);
    else if constexpr (PH == BK_FEAT1) bk_feat1(p);
    else if constexpr (PH == BK_FEAT2) bk_feat2(p, lds);
    else if constexpr (PH == BK_MIXOUT) bk_mixout(p);
    else if constexpr (PH == BK_MLANORM) bk_mlanorm(p);
    else if constexpr (PH == BK_NORM02D) bk_norm_router(p, lds, 0, 0, true);
    else if constexpr (PH == BK_UQ_UKV) { bk_ukv_split(p, lds); bk_uq_rope(p, lds); }
    else if constexpr (PH == BK_RWKVP) bk_rwkv_chunk2<0>(p, lds);
    else if constexpr (PH == BK_RWKVC) bk_rwkv_chunk<0>(p, lds);
    else if constexpr (PH == BK_RWKVQ) { bk_rwkv_chunk3(p, lds); if (gridDim.x >= 512) { bk_mod(p, lds, 1, 2, 256); bk_convert_dense(p, lds, 1, 256); bk_convert_moe(p, lds, 0, 256); } }
    else if constexpr (PH == BK_PROLOGUE) { if (gridDim.x >= 512) { bk_mod(p, lds, 0, 1, 0); bk_convert_dense(p, lds, 0, 0); } else { bk_mod(p, lds); bk_convert_dense(p, lds); bk_convert_moe(p, lds, 0); } }
    else if constexpr (PH == BK_RETD_FEAT1) { bk_ret_delta(p, lds); bk_feat1(p); }
    else if constexpr (PH == BK_RWKV_CONV) { bk_ret_out(p, lds); }
    else if constexpr (PH == BK_NORM11_CONV) { bk_norm(p, 1, 1, 0); bk_convert_moe(p, lds, 1); }
}
#define FORWARD_PROGRAM(X, XB, XB0, CK) \
    XB0(BK_PROLOGUE, 0) \
    XB(BK_NORM01, 0) XB(BK_EVIN, 0) XB(BK_RETD_FEAT1, 0) XB(BK_RETP, 0) XB(BK_RWKV_CONV, 0) XB(BK_FEAT2, 0) \
    XB(BK_RWKVQ, 0) XB(BK_MIXOUT, 0) XB(BK_WOUT, 0) CK("mix0") \
    XB(BK_NORM02, 0) XB(BK_MOEH, 0) XB(BK_MOED, 0) CK("moe0") \
    XB(BK_NORM11_CONV, 0) XB(BK_MLAIN, 0) XB(BK_MLANORM, 0) XB(BK_UQ_UKV, 0) XB(BK_ATTN, 0) \
    XB(BK_WO, 0) CK("mix1") \
    XB(BK_NORM12, 0) XB(BK_MOEH, 1) XB(BK_MOED, 1) CK("moe1") \
    XB(BK_FINAL, 0)

#ifndef HOST_EMU
#define MEGA_XB(PH, a0) run_bphase<PH>(p, lds, a0); { XcdBarrier xb_; xb_.bar = p.bar(); xb_.x = xb_xcc_id(); xb_.st = (volatile LAS unsigned*)&xb_words; xcd_barrier(xb_); }
#define MEGA_XB0(PH, a0) run_bphase<PH>(p, lds, a0); grid.sync();
#define MEGA_CK(name)
__global__ void __launch_bounds__(256, 2) mega_kernel(Params p) {
    cg::grid_group grid = cg::this_grid();
    LDS_ARRAY(lds, LDS_BYTES);
    __shared__ uint4 xb_words;
    if (threadIdx.x == 0) xb_words = make_uint4(0u, 0u, 0u, 0u);
    __syncthreads();
    (void)xcd_barrier_post(p.bar(), (volatile LAS unsigned*)&xb_words);
    FORWARD_PROGRAM(0, MEGA_XB, MEGA_XB0, MEGA_CK)
}
#else
void emu_checkpoint(const char* name, const Params& p);
#ifndef EMU_GRID
#define EMU_GRID 16
#endif
#define EMU_XB(PH, a0) emu_launch(EMU_GRID, 256, [&]() { LDS_ARRAY(lds_, LDS_BYTES); run_bphase<PH>(p, lds_, a0); });
#define EMU_CK(name) emu_checkpoint(name, p);
#endif

extern "C" void kernel_launch(void* const* d_in, const int* in_sizes, int n_in, void* d_out, int out_size, void* d_ws, size_t ws_size, hipStream_t stream) {
    (void)in_sizes; (void)n_in; (void)out_size;
    if (WL.total > ws_size) { fprintf(stderr, "workspace too small: need %zu have %zu\n", (size_t)WL.total, ws_size); return; }
    Params p{};
    const float* const* in = (const float* const*)d_in;
    p.x = in[0]; p.c = in[1]; p.ctx = in[2]; p.c_ctx = in[3]; p.ada_w = in[4]; p.ada_b = in[5]; p.norm1_g = in[6]; p.norm2_g = in[7]; p.final_g = in[8];
    p.ev_w_in = in[9]; p.ev_shift_mu = in[10]; p.rwkv_w0 = in[11]; p.rwkv_w2 = in[12]; p.rwkv_a0 = in[13]; p.rwkv_a2 = in[14]; p.rwkv_g2 = in[15];
    p.rwkv_k_k = in[16]; p.rwkv_k_a = in[17]; p.rwkv_r_k = in[18]; p.rwkv_lnx_w = in[19]; p.rwkv_lnx_b = in[20]; p.ev_w_out = in[21];
    p.mla_w_in = in[22]; p.mla_q_norm_g = in[23]; p.mla_w_uq = in[24]; p.mla_kv_norm_g = in[25]; p.mla_w_ukv = in[26]; p.mla_w_o = in[27];
    p.moe_w_grp = in[28]; p.moe_b_grp = in[29]; p.moe_w_exp = in[30]; p.moe_b_exp = in[31]; p.moe_w_gate = in[32]; p.moe_w_up = in[33]; p.moe_w_down = in[34];
    p.out = (float*)d_out; p.ws = (char*)d_ws;
#ifdef HOST_EMU
    FORWARD_PROGRAM(0, EMU_XB, EMU_XB, EMU_CK)
#else
    static int grid_blocks = 0;
    if (!grid_blocks) {
        int dev = 0, cus = 0, per_cu = 0;
        (void)hipGetDevice(&dev); (void)hipDeviceGetAttribute(&cus, hipDeviceAttributeMultiprocessorCount, dev);
        (void)hipOccupancyMaxActiveBlocksPerMultiprocessor(&per_cu, mega_kernel, 256, 0);
        if (per_cu > 2) per_cu = 2;
        grid_blocks = cus * per_cu;
    }
    (void)hipMemsetAsync(d_ws, 0, 16384, stream);
    void* args[] = {&p};
    hipError_t e = hipLaunchCooperativeKernel((void*)mega_kernel, dim3(grid_blocks), dim3(256), args, 0, stream);
    if (e != hipSuccess) fprintf(stderr, "cooperative launch failed: %s (grid %d)\n", hipGetErrorString(e), grid_blocks);
#endif
}
```

```cpp
#ifndef HOST_EMU
#include <hip/hip_runtime.h>
#include <hip/hip_cooperative_groups.h>
#include <cstdio>
namespace cg = cooperative_groups;
#define DEVFN __device__ __forceinline__
#define DEVNI __device__ __forceinline__
typedef short bf16x8 __attribute__((ext_vector_type(8)));
typedef short bf16x4 __attribute__((ext_vector_type(4)));
typedef float f32x4 __attribute__((ext_vector_type(4)));
typedef float f32x16 __attribute__((ext_vector_type(16)));
#define MFMA16(a, b, c) __builtin_amdgcn_mfma_f32_16x16x32_bf16(a, b, c, 0, 0, 0)
#define MFMA32(a, b, c) __builtin_amdgcn_mfma_f32_32x32x16_bf16(a, b, c, 0, 0, 0)
template <int M> __device__ __forceinline__ float shfl_xor_c(float v) { static_assert(M > 0 && M < 32, "swizzle range"); return __builtin_bit_cast(float, __builtin_amdgcn_ds_swizzle(__builtin_bit_cast(int, v), (M << 10) | 0x1f)); }
#define SHFL_XOR(v, m) shfl_xor_c<m>(v)
#define SWAP32_(v) float a_ = v, b_ = v; asm volatile("s_nop 1\n\tv_permlane32_swap_b32 %0, %1" : "+v"(a_), "+v"(b_));
__device__ __forceinline__ float sum_xor32(float v) { SWAP32_(v) return a_ + b_; }
__device__ __forceinline__ float max_xor32(float v) { SWAP32_(v) return fmaxf(a_, b_); }
#define SUM_XOR32(v) sum_xor32(v)
#define MAX_XOR32(v) max_xor32(v)
#define WAVE_ANY(c) (__builtin_amdgcn_ballot_w64(c) != 0ull)
#define WAVE_BALLOT(c) __builtin_amdgcn_ballot_w64(c)
#define WAVE_FIRST(x) __builtin_amdgcn_readfirstlane(x)
#define WAVE_SYNC() { __builtin_amdgcn_fence(__ATOMIC_RELEASE, "wavefront"); __builtin_amdgcn_wave_barrier(); __builtin_amdgcn_fence(__ATOMIC_ACQUIRE, "wavefront"); }
#define SPIN_PAUSE() __builtin_amdgcn_s_sleep(1)
#define LDS_CNT_ADD(p_, v_) (void)__hip_atomic_fetch_add((__attribute__((address_space(3))) int*)(p_), (v_), __ATOMIC_RELAXED, __HIP_MEMORY_SCOPE_WORKGROUP)
#define LDS_CNT_LOAD(p_) __hip_atomic_load((__attribute__((address_space(3))) int*)(p_), __ATOMIC_RELAXED, __HIP_MEMORY_SCOPE_WORKGROUP)
#define SETPRIO(n) __builtin_amdgcn_s_setprio(n)
#define OPAQUE4V(a, b, c, d) asm volatile("" : "+v"(a), "+v"(b), "+v"(c), "+v"(d));
#define PERMLANE16_SWAP(a, b) { const auto r_ = __builtin_amdgcn_permlane16_swap((a), (b), false, false); const unsigned r0_ = r_[0], r1_ = r_[1]; (a) = r0_; (b) = r1_; }
#define PERMLANE32_SWAP(a, b) { const auto r_ = __builtin_amdgcn_permlane32_swap((a), (b), false, false); const unsigned r0_ = r_[0], r1_ = r_[1]; (a) = r0_; (b) = r1_; }
#define LDS_ARRAY(name, bytes) __shared__ __attribute__((aligned(16))) unsigned char name[bytes]
__device__ __forceinline__ int tid_opaque() { int t = threadIdx.x; asm volatile("" : "+v"(t)); return t; }
#define TIDX tid_opaque()
__device__ __forceinline__ int grid_opaque() { int g = gridDim.x; asm volatile("" : "+s"(g)); return g; }
#define GRIDX grid_opaque()
#else
#define DEVFN inline
#define DEVNI
#define __global__
typedef void* hipStream_t;
static inline float rsqrtf(float x) { return 1.0f / sqrtf(x); }
#define MFMA16(a, b, c) emu_mfma16(a, b, c)
#define MFMA32(a, b, c) emu_mfma32(a, b, c)
#define SHFL_XOR(v, m) emu_shfl_xor(v, m)
#define SUM_XOR32(v) ((v) + emu_shfl_xor(v, 32))
#define MAX_XOR32(v) fmaxf(v, emu_shfl_xor(v, 32))
#define WAVE_ANY(c) (emu_ballot(c) != 0ull)
#define WAVE_BALLOT(c) emu_ballot(c)
#define WAVE_FIRST(x) (x)
#define WAVE_SYNC() emu_wave_barrier();
#define SPIN_PAUSE() emu_yield()
#define LDS_CNT_ADD(p_, v_) (void)atomicAdd((int*)(p_), (v_))
#define LDS_CNT_LOAD(p_) (*(volatile int*)(p_))
#define SETPRIO(n)
#define OPAQUE4V(a, b, c, d) ;
#define PERMLANE32_SWAP(a, b) { const int l_ = emu_lane(); const unsigned a_ = (a), b_ = (b); const unsigned bl_ = emu_shfl(b_, l_ - 32), ah_ = emu_shfl(a_, l_ + 32); if (l_ >= 32) (a) = bl_; else (b) = ah_; }
#define PERMLANE16_SWAP(a, b) { const int l_ = emu_lane(); const unsigned a_ = (a), b_ = (b); const unsigned bl_ = emu_shfl(b_, l_ - 16), ah_ = emu_shfl(a_, l_ + 16); if ((l_ >> 4) & 1) (a) = bl_; else (b) = ah_; }
#define LDS_ARRAY(name, bytes) static thread_local __attribute__((aligned(16))) unsigned char name[bytes]
#define TIDX ((int)threadIdx.x)
#define GRIDX ((int)gridDim.x)
#endif
#include <cstddef>

#ifndef NB
#define NB 8
#endif
#ifndef NL
#define NL 2048
#endif
#ifndef NC
#define NC 256
#endif

typedef unsigned short bf16_t;

constexpr int D = 1024;
constexpr int SQ = NC + NL;
constexpr int TC = NB * NC;
constexpr int TL = NB * NL;
constexpr int T = TC + TL;
constexpr int EVEN_IN = 3488, SHIFT_W = 1952, NRET = 1536, NLIN = 416, LIN_LD = 448;
constexpr int NMOD = 6 * D;
constexpr float EPS = 1e-6f, GN_EPS = 64e-5f;

DEVFN float bf2f(bf16_t v) { unsigned u = ((unsigned)v) << 16; float f; memcpy(&f, &u, 4); return f; }
#ifndef HOST_EMU
DEVFN bf16_t f2bf(float f) { return __builtin_bit_cast(bf16_t, (__bf16)f); }
#else
DEVFN bf16_t f2bf(float f) { unsigned u; memcpy(&u, &f, 4); u += 0x7FFFu + ((u >> 16) & 1u); return (bf16_t)(u >> 16); }
#endif
#ifndef HOST_EMU
#define FAST_EXP2(x) __builtin_amdgcn_exp2f(x)
#define FAST_RCP(x) __builtin_amdgcn_rcpf(x)
#else
#define FAST_EXP2(x) exp2f(x)
#define FAST_RCP(x) (1.0f / (x))
#endif
typedef float f32x2 __attribute__((ext_vector_type(2)));
DEVFN float fast_sigmoid(float x) { return FAST_RCP(1.0f + FAST_EXP2(-1.4426950408889634f * x)); }
DEVFN float fast_silu(float x) { return x * fast_sigmoid(x); }
DEVFN float sigmoidf_(float x) { return 1.0f / (1.0f + expf(-x)); }
DEVFN float siluf_(float x) { return x / (1.0f + expf(-x)); }

constexpr int EVIN_NP = 3584;
constexpr int RCH = 128, NCC = NC / RCH, NLC = NL / RCH, NCH = NCC + NLC;
struct WsLayout { size_t hb, wrt, ys, fnrm, mod, eidx, ew, bonus, mcnt,  wts, wmoe, A, prw, lin, yf, fv, fgate, fkka1, fkt0, fkt1, mixr, mixw, retS, mlist, hid, qkva, cq, ckv, kpe, qb, kn, vT, ao, total; };
constexpr size_t al256(size_t x) { return (x + 255) & ~(size_t)255; }
constexpr WsLayout make_layout() {
    WsLayout w{}; size_t o = 16384;
    w.mod = o; o = al256(o + (size_t)2 * (NB + 1) * NMOD * 4);
    w.eidx = o; o = al256(o + (size_t)T * 2 * 4);
    w.ew = o; o = al256(o + (size_t)T * 2 * 4);
    w.bonus = o; o = al256(o + (size_t)T * 8 * 4);
    w.fnrm = o; o = al256(o + (size_t)T * 8 * 4);
    w.mcnt = o; o = al256(o + 64 * 4 + 1024 * 8);
    w.wts = o; o = al256(o + (size_t)(EVIN_NP * D + D * D + 768 * D + 1536 * 384 + 2048 * 256 + D * D + 2 * 512 * 64 + 2 * 512 * 64 + 512 * 192) * 2);
    w.wrt = o; o = al256(o + (size_t)4 * 48 * D * 2);
    w.wmoe = o; o = al256(o + (size_t)32 * (512 * D + D * 256) * 2);
    w.A = o; o = al256(o + (size_t)T * D * 2);
    const size_t pool = o; const size_t fs = al256((size_t)T * 512 * 2);
    w.prw = o; o = al256(o + (size_t)T * SHIFT_W * 2);
    w.lin = o; o = al256(o + (size_t)T * LIN_LD * 2);
    w.yf = w.prw;
    if ((size_t)2 * T * 512 * 4 > o - w.prw) o = al256(w.prw + (size_t)2 * T * 512 * 4);
    w.fv = o; o += fs; w.fgate = o; o += fs; w.fkka1 = o; o += fs; w.fkt0 = o; o += fs; w.fkt1 = o; o += fs;
    w.mixr = o; o += fs; w.mixw = o; o += fs;
    w.retS = o; o = al256(o + (size_t)NB * 4 * 2 * NCH * 8192 * 2);
    const size_t end0 = o;
    w.hb = w.prw;
    w.mlist = w.mixr; w.hid = 0  ; w.ys = al256(w.hb + (size_t)T * D * 2);
    if (w.ys + (size_t)T * 2 * D * 2 > w.mixr) w.ys = ~(size_t)0;
    o = al256(w.hb + (size_t)T * D * 2);
    w.qkva = o; o = al256(o + (size_t)T * 704 * 2);
    w.cq = 0; w.ckv = 0; w.kpe = 0;
    w.qb = o; o = al256(o + (size_t)TL * 1536 * 2);
    w.kn = o; o = al256(o + (size_t)T * 1024 * 2);
    w.vT = o; o = al256(o + (size_t)T * 1024 * 2);
    w.ao = 0;
    w.total = end0 > o ? end0 : o;
    return w;
}

constexpr WsLayout WL = make_layout();
static_assert(WL.ys != ~(size_t)0, "ys overlaps mlist");
static_assert((size_t)T * 704 * 2 + (size_t)TL * D * 2 <= (size_t)TL * D * 4 && (size_t)T * 2 * 256 * 2 <= (size_t)TL * D * 4, "d_out scratch capacity");
static_assert(NB != 8 || NL != 2048 || NC != 256 || WL.total <= 358461472ull, "workspace budget");

struct Params {
    const float *x, *c, *ctx, *c_ctx, *ada_w, *ada_b, *norm1_g, *norm2_g, *final_g;
    const float *ev_w_in, *ev_shift_mu, *rwkv_w0, *rwkv_w2, *rwkv_a0, *rwkv_a2, *rwkv_g2, *rwkv_k_k, *rwkv_k_a, *rwkv_r_k, *rwkv_lnx_w, *rwkv_lnx_b, *ev_w_out;
    const float *mla_w_in, *mla_q_norm_g, *mla_w_uq, *mla_kv_norm_g, *mla_w_ukv, *mla_w_o;
    const float *moe_w_grp, *moe_b_grp, *moe_w_exp, *moe_b_exp, *moe_w_gate, *moe_w_up, *moe_w_down;
    float* out;
    char* ws;
    int cg_sync, pad_;
#define WSF(type, name, off) DEVFN type* name() const { return (type*)(ws + (off)); }
    WSF(unsigned, bar, 0)
    WSF(float, mod, WL.mod) WSF(int, eidx, WL.eidx) WSF(float, ew, WL.ew) WSF(float, bonus, WL.bonus) WSF(float, fnrm, WL.fnrm)
    WSF(int, mcnt, WL.mcnt) WSF(float, ropetab, WL.mcnt + 256) WSF(bf16_t, hb, WL.hb)
    WSF(bf16_t, xn, WL.A) WSF(bf16_t, fr, WL.A) WSF(bf16_t, fkk, WL.A + (size_t)T * 512 * 2)
    WSF(bf16_t, prw, WL.prw) WSF(bf16_t, lin, WL.lin) WSF(bf16_t, yf, WL.yf) WSF(bf16_t, ybw, WL.yf + (size_t)T * 512 * 2)
    WSF(bf16_t, fv, WL.fv) WSF(bf16_t, fgate, WL.fgate) WSF(bf16_t, fkka1, WL.fkka1) WSF(bf16_t, fkt0, WL.fkt0) WSF(bf16_t, fkt1, WL.fkt1)
    WSF(bf16_t, mixr, WL.mixr) WSF(bf16_t, mixw, WL.mixw) WSF(bf16_t, retS, WL.retS) WSF(int, mlist, WL.mlist) WSF(bf16_t, ys, WL.ys)
    WSF(bf16_t, qkva, WL.qkva) WSF(bf16_t, qb, WL.qb) WSF(bf16_t, kn, WL.kn) WSF(bf16_t, vT, WL.vT)
    WSF(bf16_t, wt_evin, WL.wts) WSF(bf16_t, wt_evout, WL.wts + (size_t)2 * EVIN_NP * D) WSF(bf16_t, wt_mlain, WL.wts + (size_t)2 * (EVIN_NP * D + D * D))
    WSF(bf16_t, wt_uq, WL.wts + (size_t)2 * (EVIN_NP * D + D * D + 768 * D)) WSF(bf16_t, wt_ukv, WL.wts + (size_t)2 * (EVIN_NP * D + D * D + 768 * D + 1536 * 384))
    WSF(bf16_t, wt_wo, WL.wts + (size_t)2 * (EVIN_NP * D + D * D + 768 * D + 1536 * 384 + 2048 * 256))
    WSF(bf16_t, wt_w2, WL.wts + (size_t)2 * (EVIN_NP * D + 2 * D * D + 768 * D + 1536 * 384 + 2048 * 256))
    WSF(bf16_t, wt_a2, WL.wts + (size_t)2 * (EVIN_NP * D + 2 * D * D + 768 * D + 1536 * 384 + 2048 * 256 + 2 * 512 * 64))
    WSF(bf16_t, wt_g2, WL.wts + (size_t)2 * (EVIN_NP * D + 2 * D * D + 768 * D + 1536 * 384 + 2048 * 256 + 4 * 512 * 64))
    WSF(bf16_t, wr_hi, WL.wrt) WSF(bf16_t, wr_lo, WL.wrt + (size_t)2 * 48 * D * 2)
    WSF(bf16_t, wt_gu, WL.wmoe) WSF(bf16_t, wt_dn, WL.wmoe + (size_t)2 * 32 * 512 * D)
#undef WSF
    DEVFN bf16_t* pret() const { return (bf16_t*)out; }
    DEVFN bf16_t* hid() const { return (bf16_t*)out; }
    DEVFN bf16_t* cq() const { return (bf16_t*)out; }
    DEVFN bf16_t* ckv() const { return (bf16_t*)out + (size_t)T * 384; }
    DEVFN bf16_t* kpe() const { return (bf16_t*)out + (size_t)T * 640; }
    DEVFN bf16_t* ao() const { return (bf16_t*)out + (size_t)T * 704; }
    DEVFN bf16_t* fomw0() const { return (bf16_t*)out; }
    DEVFN bf16_t* fomw1() const { return (bf16_t*)out + (size_t)T * 512; }
    DEVFN bf16_t* fkka0() const { return (bf16_t*)out + (size_t)2 * T * 512; }
};

DEVFN bf16_t* hrow(const Params& p, int tk) { return p.hb() + (size_t)tk * D; }
DEVFN const float* hin(const Params& p, int tk) { return tk < TC ? p.ctx + (size_t)tk * D : p.x + (size_t)(tk - TC) * D; }
DEVFN int modrow(int tk) { return tk < TC ? NB : (tk - TC) / NL; }
DEVFN const float* modp(const Params& p, int layer, int mr, int which) { return p.mod() + (((size_t)layer * (NB + 1) + mr) * 6 + which) * D; }
DEVFN int scan_tok(int b, int dir, int step) {
    if (step < NC) return b * NC + (dir ? NC - 1 - step : step);
    const int t = step - NC; return TC + b * NL + (dir ? NL - 1 - t : t);
}
DEVFN int key_tok(int b, int key) { return key < NC ? b * NC + key : TC + b * NL + (key - NC); }

typedef unsigned u32x4 __attribute__((ext_vector_type(4)));
typedef unsigned u32x2 __attribute__((ext_vector_type(2)));
constexpr int GBM = 128, GBN = 128, GBK = 64;
constexpr int G_STAGE = (GBM + GBN) * GBK * 2;
constexpr int LDS_BYTES = 2 * G_STAGE + 2048 + 512;
#ifndef HOST_EMU
typedef __bf16 bf16n2 __attribute__((ext_vector_type(2)));
typedef float f32n2 __attribute__((ext_vector_type(2)));
DEVFN unsigned pack2bf(float a, float b) { const f32n2 v = {a, b}; return __builtin_bit_cast(unsigned, __builtin_convertvector(v, bf16n2)); }
#else
DEVFN unsigned pack2bf(float a, float b) { return (unsigned)f2bf(a) | ((unsigned)f2bf(b) << 16); }
#endif
DEVFN u32x2 pack4bf(f32x4 v) { u32x2 r; r.x = pack2bf(v[0], v[1]); r.y = pack2bf(v[2], v[3]); return r; }
DEVFN u32x4 pair16(u32x2 a, u32x2 b) {
    PERMLANE16_SWAP(a.x, b.x) PERMLANE16_SWAP(a.y, b.y)
    u32x4 w; w.x = a.x; w.y = a.y; w.z = b.x; w.w = b.y; return w;
}
DEVFN int pair16_col(int fq) { return (fq & 1) ? 16 + 4 * (fq - 1) : 4 * fq; }
DEVFN void st16_pair(bf16_t* rowp, int fq, u32x2 a, u32x2 b) { const u32x4 w = pair16(a, b); *(u32x4*)(rowp + pair16_col(fq)) = w; }
DEVFN void st16_pair32(bf16_t* rowp, int hh, u32x2 a, u32x2 b) {
    PERMLANE32_SWAP(a.x, b.x) PERMLANE32_SWAP(a.y, b.y)
    u32x4 w; w.x = a.x; w.y = a.y; w.z = b.x; w.w = b.y;
    *(u32x4*)(rowp + 8 * hh) = w;
}
DEVFN f32x4 ld4bf(const bf16_t* q) { const u32x2 w = *(const u32x2*)q; f32x4 r; r[0] = __builtin_bit_cast(float, w.x << 16); r[1] = __builtin_bit_cast(float, w.x & 0xffff0000u); r[2] = __builtin_bit_cast(float, w.y << 16); r[3] = __builtin_bit_cast(float, w.y & 0xffff0000u); return r; }

struct GemmSrcA {
    const bf16_t* base; int ld;
    const bf16_t* base2; int ld2; int ksplit;
    const int* rowidx; int nvalid; int rowshift;
};
DEVFN GemmSrcA plainA(const bf16_t* base, int ld) { GemmSrcA a; a.base = base; a.ld = ld; a.base2 = base; a.ld2 = ld; a.ksplit = 1 << 30; a.rowidx = nullptr; a.nvalid = 0; a.rowshift = 0; return a; }

template <bool TRANS, class Epi>
DEVFN void gemm_tile(unsigned char* lds, const GemmSrcA& A, int m0, const bf16_t* Bt, int ldb, int n0, int K, Epi epi) {
    const int tid = TIDX, lane = tid & 63, wave = tid >> 6, wm = wave >> 1, wn = wave & 1, fr = lane & 15, fq = lane >> 4;
    const int lr = tid >> 3, kc = tid & 7;
    const bf16_t* pA[4]; const bf16_t* pA2[4]; const bf16_t* pB[4]; int soff[4];
#pragma unroll
    for (int i = 0; i < 4; ++i) {
        const int r = lr + 32 * i; int gr = m0 + r;
        if (A.rowidx) { const int q = gr < A.nvalid ? gr : A.nvalid - 1; gr = A.rowidx[q] >> A.rowshift; }
        pA[i] = A.base + (size_t)gr * A.ld + kc * 8; pA2[i] = A.base2 + (size_t)gr * A.ld2 + kc * 8 - A.ksplit;
        pB[i] = Bt + (size_t)(n0 + r) * ldb + kc * 8;
        soff[i] = r * 128 + ((kc ^ ((r >> 1) & 7)) << 4);
    }
    f32x4 acc[4][4];
#pragma unroll
    for (int mi = 0; mi < 4; ++mi)
#pragma unroll
        for (int ni = 0; ni < 4; ++ni) acc[mi][ni] = (f32x4){0.f, 0.f, 0.f, 0.f};
    u32x4 ra[4], rb[4], ra2[4], rb2[4];
    const int nk = K / GBK;
#define G_GLOADX(kt, RA, RB) { const int k0_ = (kt) * GBK; _Pragma("unroll") for (int i = 0; i < 4; ++i) { RA[i] = *(const u32x4*)((k0_ < A.ksplit ? pA[i] : pA2[i]) + k0_); RB[i] = *(const u32x4*)(pB[i] + k0_); } }
#define G_LSTOREX(st, RA, RB) { unsigned char* sb_ = lds + (st) * G_STAGE; _Pragma("unroll") for (int i = 0; i < 4; ++i) { *(u32x4*)(sb_ + soff[i]) = RA[i]; *(u32x4*)(sb_ + 16384 + soff[i]) = RB[i]; } }
#define G_COMPUTE(kt) { const unsigned char* sa = lds + ((kt) & 1) * G_STAGE; const unsigned char* sb = sa + 16384; \
        _Pragma("unroll") for (int ks = 0; ks < 2; ++ks) { bf16x8 af[4], bfr[4]; const int ch = ks * 4 + fq; \
            _Pragma("unroll") for (int i = 0; i < 4; ++i) { const int ra_ = wm * 64 + i * 16 + fr, rb_ = wn * 64 + i * 16 + fr; \
                af[i] = *(const bf16x8*)(sa + ra_ * 128 + ((ch ^ ((ra_ >> 1) & 7)) << 4)); bfr[i] = *(const bf16x8*)(sb + rb_ * 128 + ((ch ^ ((rb_ >> 1) & 7)) << 4)); } \
            SETPRIO(1); _Pragma("unroll") for (int mi = 0; mi < 4; ++mi) _Pragma("unroll") for (int ni = 0; ni < 4; ++ni) acc[mi][ni] = TRANS ? MFMA16(bfr[ni], af[mi], acc[mi][ni]) : MFMA16(af[mi], bfr[ni], acc[mi][ni]); SETPRIO(0); } }
    G_GLOADX(0, ra, rb) G_LSTOREX(0, ra, rb)
    if (nk > 1) G_GLOADX(1, ra, rb)
    if (nk > 2) G_GLOADX(2, ra2, rb2)
    __syncthreads();
    for (int kt = 0; kt < nk; kt += 2) {
        if (kt + 1 < nk) { G_LSTOREX((kt + 1) & 1, ra, rb) if (kt + 3 < nk) G_GLOADX(kt + 3, ra, rb) }
        G_COMPUTE(kt)
        __syncthreads();
        if (kt + 1 < nk) {
            if (kt + 2 < nk) { G_LSTOREX((kt + 2) & 1, ra2, rb2) if (kt + 4 < nk) G_GLOADX(kt + 4, ra2, rb2) }
            G_COMPUTE(kt + 1)
            __syncthreads();
        }
    }
#undef G_GLOADX
#undef G_LSTOREX
#undef G_COMPUTE
#define G_GLOAD(x)
#define G_LSTORE(x)
#undef G_GLOAD
#undef G_LSTORE
    epi(acc, m0 + wm * 64, n0 + wn * 64, fr, fq);
}


constexpr int GBM2 = 256, GBK2 = 32, G2_STAGE = (GBM2 + GBN) * GBK2 * 2;
static_assert(2 * G2_STAGE <= LDS_BYTES, "gemm2 LDS");
template <bool TRANS, class Epi>
DEVFN void gemm_tile2(unsigned char* lds, const GemmSrcA& A, int m0, const bf16_t* Bt, int ldb, int n0, int K, Epi epi) {
    const int tid = TIDX, lane = tid & 63, wave = tid >> 6, wm = wave >> 1, wn = wave & 1, fr = lane & 15, fq = lane >> 4;
    const int lr = tid >> 2, kc = tid & 3;
    const bf16_t* pA[4]; const bf16_t* pB[2]; int sA[4], sB[2];
#pragma unroll
    for (int i = 0; i < 4; ++i) { const int r = lr + 64 * i; pA[i] = A.base + (size_t)(m0 + r) * A.ld + kc * 8; sA[i] = r * 64 + ((kc ^ ((r >> 2) & 3)) << 4); }
#pragma unroll
    for (int i = 0; i < 2; ++i) { const int r = lr + 64 * i; pB[i] = Bt + (size_t)(n0 + r) * ldb + kc * 8; sB[i] = GBM2 * 64 + r * 64 + ((kc ^ ((r >> 2) & 3)) << 4); }
    f32x4 acc[2][4][4];
#pragma unroll
    for (int hf = 0; hf < 2; ++hf)
#pragma unroll
        for (int mi = 0; mi < 4; ++mi)
#pragma unroll
            for (int ni = 0; ni < 4; ++ni) acc[hf][mi][ni] = (f32x4){0.f, 0.f, 0.f, 0.f};
    u32x4 ra[4], rb[2], ra2[4], rb2[2];
    const int nk = K / GBK2;
#define G2_GLOAD(kt, RA, RB) { const int k0_ = (kt) * GBK2; _Pragma("unroll") for (int i = 0; i < 4; ++i) RA[i] = *(const u32x4*)(pA[i] + k0_); _Pragma("unroll") for (int i = 0; i < 2; ++i) RB[i] = *(const u32x4*)(pB[i] + k0_); }
#define G2_LSTORE(st, RA, RB) { unsigned char* sb_ = lds + (st) * G2_STAGE; _Pragma("unroll") for (int i = 0; i < 4; ++i) *(u32x4*)(sb_ + sA[i]) = RA[i]; _Pragma("unroll") for (int i = 0; i < 2; ++i) *(u32x4*)(sb_ + sB[i]) = RB[i]; }
#define G2_COMPUTE(kt) { const unsigned char* sa = lds + ((kt) & 1) * G2_STAGE; const unsigned char* sb = sa + GBM2 * 64; bf16x8 bfr[4]; \
        _Pragma("unroll") for (int i = 0; i < 4; ++i) { const int r = wn * 64 + i * 16 + fr; bfr[i] = *(const bf16x8*)(sb + r * 64 + ((fq ^ ((r >> 2) & 3)) << 4)); } \
        SETPRIO(1); \
        _Pragma("unroll") for (int hf = 0; hf < 2; ++hf) _Pragma("unroll") for (int mi = 0; mi < 4; ++mi) { const int r = wm * 128 + hf * 64 + mi * 16 + fr; const bf16x8 af = *(const bf16x8*)(sa + r * 64 + ((fq ^ ((r >> 2) & 3)) << 4)); \
            _Pragma("unroll") for (int ni = 0; ni < 4; ++ni) acc[hf][mi][ni] = TRANS ? MFMA16(bfr[ni], af, acc[hf][mi][ni]) : MFMA16(af, bfr[ni], acc[hf][mi][ni]); } \
        SETPRIO(0); }
    G2_GLOAD(0, ra, rb) G2_LSTORE(0, ra, rb)
    if (nk > 1) G2_GLOAD(1, ra, rb)
    if (nk > 2) G2_GLOAD(2, ra2, rb2)
    __syncthreads();
    for (int kt = 0; kt < nk; kt += 2) {
        if (kt + 1 < nk) { G2_LSTORE((kt + 1) & 1, ra, rb) if (kt + 3 < nk) G2_GLOAD(kt + 3, ra, rb) }
        G2_COMPUTE(kt)
        __syncthreads();
        if (kt + 1 < nk) {
            if (kt + 2 < nk) { G2_LSTORE((kt + 2) & 1, ra2, rb2) if (kt + 4 < nk) G2_GLOAD(kt + 4, ra2, rb2) }
            G2_COMPUTE(kt + 1)
            __syncthreads();
        }
    }
#undef G2_COMPUTE
#undef G2_GLOAD
#undef G2_LSTORE
    epi(acc[0], m0 + wm * 128, n0 + wn * 64, fr, fq);
    epi(acc[1], m0 + wm * 128 + 64, n0 + wn * 64, fr, fq);
}

struct ConvJob { const float* src; int ldsrc, K, N; bf16_t* dst; int Kpad, Npad, mode; };
DEVFN int conv_tiles(const ConvJob& j) { return (j.Npad / 64) * (j.Kpad / 64); }
DEVFN void conv_load(const ConvJob& j, int tile, f32x4 (&v)[4]) {
    const int tid = TIDX; const int ntn = j.Npad / 64, tn = tile % ntn, tk = tile / ntn; const int r = tid >> 4, c4 = (tid & 15) * 4;
#pragma unroll
    for (int i = 0; i < 4; ++i) { const int k = tk * 64 + r + 16 * i, n = tn * 64 + c4; v[i] = (f32x4){0.f, 0.f, 0.f, 0.f};
        if (k < j.K && n < j.N) v[i] = __builtin_nontemporal_load((const f32x4*)(j.src + (size_t)k * j.ldsrc + n)); }
}
DEVFN void conv_stash(unsigned char* lds, const f32x4 (&v)[4]) {
    float* t = (float*)lds; const int tid = TIDX; const int r = tid >> 4, c4 = (tid & 15) * 4;
#pragma unroll
    for (int i = 0; i < 4; ++i) { float* d = t + (r + 16 * i) * 65 + c4; d[0] = v[i][0]; d[1] = v[i][1]; d[2] = v[i][2]; d[3] = v[i][3]; }
}
DEVFN void conv_emit(unsigned char* lds, const ConvJob& j, int tile) {
    float* t = (float*)lds; const int tid = TIDX; const int ntn = j.Npad / 64, tn = tile % ntn, tk = tile / ntn;
    { const int nl = tid >> 2, kq = (tid & 3) * 16; int row = tn * 64 + nl;
      if (j.mode) { const int c = row; row = (c >> 6) * 128 + ((c >> 5) & 1) * 64 + (c & 31) + (j.mode == 2 ? 32 : 0); }
      u32x4 o0, o1;
      o0.x = pack2bf(t[(kq + 0) * 65 + nl], t[(kq + 1) * 65 + nl]); o0.y = pack2bf(t[(kq + 2) * 65 + nl], t[(kq + 3) * 65 + nl]);
      o0.z = pack2bf(t[(kq + 4) * 65 + nl], t[(kq + 5) * 65 + nl]); o0.w = pack2bf(t[(kq + 6) * 65 + nl], t[(kq + 7) * 65 + nl]);
      o1.x = pack2bf(t[(kq + 8) * 65 + nl], t[(kq + 9) * 65 + nl]); o1.y = pack2bf(t[(kq + 10) * 65 + nl], t[(kq + 11) * 65 + nl]);
      o1.z = pack2bf(t[(kq + 12) * 65 + nl], t[(kq + 13) * 65 + nl]); o1.w = pack2bf(t[(kq + 14) * 65 + nl], t[(kq + 15) * 65 + nl]);
      bf16_t* d = j.dst + (size_t)row * j.Kpad + tk * 64 + kq; *(u32x4*)d = o0; *(u32x4*)(d + 8) = o1; }
}
DEVFN void conv_tile(unsigned char* lds, const ConvJob& j, int tile) {
    float* t = (float*)lds; const int tid = TIDX; const int ntn = j.Npad / 64, tn = tile % ntn, tk = tile / ntn;
    { const int r = tid >> 4, c4 = (tid & 15) * 4;
#pragma unroll
      for (int i = 0; i < 4; ++i) { const int k = tk * 64 + r + 16 * i, n = tn * 64 + c4; f32x4 v = (f32x4){0.f, 0.f, 0.f, 0.f};
          if (k < j.K && n < j.N) v = *(const f32x4*)(j.src + (size_t)k * j.ldsrc + n);
          float* d = t + (r + 16 * i) * 65 + c4; d[0] = v[0]; d[1] = v[1]; d[2] = v[2]; d[3] = v[3]; } }
    __syncthreads();
    { const int nl = tid >> 2, kq = (tid & 3) * 16; int row = tn * 64 + nl;
      if (j.mode) { const int c = row; row = (c >> 6) * 128 + ((c >> 5) & 1) * 64 + (c & 31) + (j.mode == 2 ? 32 : 0); }
      u32x4 o0, o1;
      o0.x = pack2bf(t[(kq + 0) * 65 + nl], t[(kq + 1) * 65 + nl]); o0.y = pack2bf(t[(kq + 2) * 65 + nl], t[(kq + 3) * 65 + nl]);
      o0.z = pack2bf(t[(kq + 4) * 65 + nl], t[(kq + 5) * 65 + nl]); o0.w = pack2bf(t[(kq + 6) * 65 + nl], t[(kq + 7) * 65 + nl]);
      o1.x = pack2bf(t[(kq + 8) * 65 + nl], t[(kq + 9) * 65 + nl]); o1.y = pack2bf(t[(kq + 10) * 65 + nl], t[(kq + 11) * 65 + nl]);
      o1.z = pack2bf(t[(kq + 12) * 65 + nl], t[(kq + 13) * 65 + nl]); o1.w = pack2bf(t[(kq + 14) * 65 + nl], t[(kq + 15) * 65 + nl]);
      bf16_t* d = j.dst + (size_t)row * j.Kpad + tk * 64 + kq; *(u32x4*)d = o0; *(u32x4*)(d + 8) = o1; }
    __syncthreads();
}
DEVFN ConvJob mkjob(const float* src, int ldsrc, int K, int N, bf16_t* dst, int Kpad, int Npad, int mode) { ConvJob j; j.src = src; j.ldsrc = ldsrc; j.K = K; j.N = N; j.dst = dst; j.Kpad = Kpad; j.Npad = Npad; j.mode = mode; return j; }
static_assert((size_t)T * NRET * 2 <= (size_t)TL * D * 4, "pret must fit in d_out");
DEVNI void bk_convert_dense(const Params& p, unsigned char* lds) {
    __syncthreads();
    ConvJob jobs[11];
    jobs[0] = mkjob(p.ev_w_in, EVEN_IN, D, EVEN_IN, p.wt_evin(), D, EVIN_NP, 0);
    jobs[1] = mkjob(p.ev_w_out, D, D, D, p.wt_evout(), D, D, 0);
    jobs[2] = mkjob(p.mla_w_in, 704, D, 704, p.wt_mlain(), D, 768, 0);
    jobs[3] = mkjob(p.mla_w_uq, 1536, 384, 1536, p.wt_uq(), 384, 1536, 0);
    jobs[4] = mkjob(p.mla_w_ukv, 2048, 256, 2048, p.wt_ukv(), 256, 2048, 0);
    jobs[5] = mkjob(p.mla_w_o, D, D, D, p.wt_wo(), D, D, 0);
    jobs[6] = mkjob(p.rwkv_w2, 512, 64, 512, p.wt_w2(), 64, 512, 0);
    jobs[7] = mkjob(p.rwkv_w2 + 64 * 512, 512, 64, 512, p.wt_w2() + 512 * 64, 64, 512, 0);
    jobs[8] = mkjob(p.rwkv_a2, 512, 64, 512, p.wt_a2(), 64, 512, 0);
    jobs[9] = mkjob(p.rwkv_a2 + 64 * 512, 512, 64, 512, p.wt_a2() + 512 * 64, 64, 512, 0);
    jobs[10] = mkjob(p.rwkv_g2, 512, 160, 512, p.wt_g2(), 192, 512, 0);
    int total = 0;
#pragma unroll
    for (int i = 0; i < 11; ++i) total += conv_tiles(jobs[i]);
#define CD_JOB(it_, J, TT) { int t_ = (it_); _Pragma("unroll") for (int i = 0; i < 11; ++i) { const int n = conv_tiles(jobs[i]); if (t_ >= 0 && t_ < n) { J = jobs[i]; TT = t_; } t_ -= n; } }
    int it = blockIdx.x;
    if (it >= total) return;
    ConvJob j = jobs[0]; int t = 0; f32x4 v[4];
    CD_JOB(it, j, t) conv_load(j, t, v);
    for (; it < total; it += gridDim.x) {
        conv_stash(lds, v);
        __syncthreads();
        const ConvJob jc = j; const int tc = t;
        if (it + (int)gridDim.x < total) { CD_JOB(it + (int)gridDim.x, j, t) conv_load(j, t, v); }
        conv_emit(lds, jc, tc);
        __syncthreads();
    }
#undef CD_JOB
}
DEVNI void bk_convert_moe(const Params& p, unsigned char* lds, int layer, int b0 = 0) {
    __syncthreads();
    if ((int)blockIdx.x < b0) return;
#define CM_JOB(it_, J, TT) { const int e = (it_) / 192, r = (it_) % 192, kind = r / 64; TT = r % 64; \
        if (kind == 0) J = mkjob(p.moe_w_gate + (size_t)(layer * 32 + e) * D * 256, 256, D, 256, p.wt_gu() + (size_t)e * 512 * D, D, 256, 1); \
        else if (kind == 1) J = mkjob(p.moe_w_up + (size_t)(layer * 32 + e) * D * 256, 256, D, 256, p.wt_gu() + (size_t)e * 512 * D, D, 256, 2); \
        else J = mkjob(p.moe_w_down + (size_t)(layer * 32 + e) * 256 * D, D, 256, D, p.wt_dn() + (size_t)e * D * 256, 256, D, 0); }
    const int step = gridDim.x - b0; int it = blockIdx.x - b0;
    if (it >= 32 * 192) return;
    ConvJob j; int t; f32x4 v[4];
    CM_JOB(it, j, t) conv_load(j, t, v);
    for (; it < 32 * 192; it += step) {
        conv_stash(lds, v);
        __syncthreads();
        const ConvJob jc = j; const int tc = t;
        if (it + step < 32 * 192) { CM_JOB(it + step, j, t) conv_load(j, t, v); }
        conv_emit(lds, jc, tc);
        __syncthreads();
    }
#undef CM_JOB
}
DEVNI void bk_evin(const Params& p, unsigned char* lds) {
    const GemmSrcA A = plainA(p.xn(), D); constexpr int NTM = T / GBM2, NTN = EVIN_NP / GBN;
    for (int it = blockIdx.x; it < NTM * NTN; it += gridDim.x) {
        const int mt = it % NTM, nt = it / NTM;
        gemm_tile2<true>(lds, A, mt * GBM2, p.wt_evin(), D, nt * GBN, D, [&](f32x4 (&acc)[4][4], int mb, int nb, int fr, int fq) {
#pragma unroll
            for (int mi = 0; mi < 4; ++mi)
#pragma unroll
                for (int np = 0; np < 2; ++np) { const int row = mb + mi * 16 + fr, c0 = nb + np * 32;
                    const float sc = c0 < 256 ? 0.125f : 1.0f; const u32x2 a = pack4bf(acc[mi][2 * np] * sc), b2 = pack4bf(acc[mi][2 * np + 1] * sc);
                    if (c0 < NRET) st16_pair(p.pret() + (size_t)row * NRET + c0, fq, a, b2);
                    else if (c0 < EVEN_IN) st16_pair(p.prw() + (size_t)row * SHIFT_W + (c0 - NRET), fq, a, b2); }
        });
    }
}


template <bool BIG>
DEVNI void bk_res_gemm(const Params& p, unsigned char* lds, const GemmSrcA& A, const bf16_t* Wt, int K, int layer, int row0  , int nrows, bool first) {
    const int ntm = nrows / (BIG ? GBM2 : GBM);
    for (int it = blockIdx.x; it < ntm * 8; it += gridDim.x) {
        const int mt = it % ntm, nt = it / ntm;
        auto epi = [&](f32x4 (&acc)[4][4], int mb, int nb, int fr, int fq) {
            f32x4 m2v[4];
            { const float* m2 = modp(p, layer, modrow(row0 + mb), 2);
#pragma unroll
              for (int ni = 0; ni < 4; ++ni) m2v[ni] = *(const f32x4*)(m2 + nb + ni * 16 + fq * 4); }
#pragma unroll
            for (int mi = 0; mi < 4; ++mi) { const int tk = row0 + mb + mi * 16 + fr; bf16_t* hr = hrow(p, tk); const float* src = hin(p, tk);
#pragma unroll
                for (int np = 0; np < 2; ++np) { u32x2 pk[2];
#pragma unroll
                    for (int e = 0; e < 2; ++e) { const int ni = 2 * np + e, col = nb + ni * 16 + fq * 4; const f32x4 sv = first ? *(const f32x4*)(src + col) : ld4bf(hr + col);
                        pk[e] = pack4bf(sv + m2v[ni] * acc[mi][ni]); }
                    st16_pair(hr + nb + np * 32, fq, pk[0], pk[1]); } }
        };
        if (BIG) gemm_tile2<true>(lds, A, mt * GBM2, Wt, K, nt * GBN, K, epi); else gemm_tile<true>(lds, A, mt * GBM, Wt, K, nt * GBN, K, epi);
    }
}
DEVNI void bk_wout(const Params& p, unsigned char* lds) { GemmSrcA A = plainA(p.mixr(), 512); A.base2 = p.mixw(); A.ld2 = 512; A.ksplit = 512; bk_res_gemm<false>(p, lds, A, p.wt_evout(), D, 0, 0, T, true); }
DEVNI void bk_wo(const Params& p, unsigned char* lds) { bk_res_gemm<true>(p, lds, plainA(p.ao(), D), p.wt_wo(), D, 1, TC, TL, false); }
DEVNI void bk_mlain(const Params& p, unsigned char* lds) {
    const GemmSrcA A = plainA(p.xn(), D); constexpr int NTM = T / GBM2, NTN = 768 / GBN;
    for (int it = blockIdx.x; it < NTM * NTN; it += gridDim.x) {
        const int mt = it % NTM, nt = it / NTM;
        gemm_tile2<true>(lds, A, mt * GBM2, p.wt_mlain(), D, nt * GBN, D, [&](f32x4 (&acc)[4][4], int mb, int nb, int fr, int fq) {
#pragma unroll
            for (int mi = 0; mi < 4; ++mi)
#pragma unroll
                for (int np = 0; np < 2; ++np) { const int row = mb + mi * 16 + fr, c0 = nb + np * 32; if (c0 < 704) st16_pair(p.qkva() + (size_t)row * 704 + c0, fq, pack4bf(acc[mi][2 * np]), pack4bf(acc[mi][2 * np + 1])); }
        });
    }
}
constexpr int LCAP = T * 2;
DEVFN bool moe_item(const int* cnt, int it, int ntn, int& e, int& mt, int& nt) {
    int t = it;
    for (int i = 0; i < 32; ++i) { const int n = ((cnt[i] + GBM - 1) / GBM) * ntn; if (t < n) { e = i; mt = t / ntn; nt = t % ntn; return true; } t -= n; }
    return false;
}
template <bool HID>
DEVNI void bk_moe_stream(const Params& p, unsigned char* lds, int layer) {
    constexpr int K = HID ? D : 256, NTN = HID ? 4 : 8, NK = K / GBK, LDA = HID ? D : 256, RSH = HID ? 1 : 0;
    static_assert(NK % 2 == 0 && NK >= 4, "pair-stepped pipeline");
    constexpr size_t WEXP = HID ? (size_t)512 * D : (size_t)D * 256;
    const int* cnt = p.mcnt() + layer * 32;
    const bf16_t* Abase = HID ? p.xn() : p.hid(); const bf16_t* Wall = HID ? p.wt_gu() : p.wt_dn();
    u32x2* stash = (u32x2*)(lds + 2 * G_STAGE);
    const int tid = TIDX, lane = tid & 63, wave = tid >> 6, wm = wave >> 1, wn = wave & 1, fr = lane & 15, fq = lane >> 4, lr = tid >> 3, kc = tid & 7;
    const int soff0 = lr * 128 + ((kc ^ ((lr >> 1) & 7)) << 4), wofs0 = lr * K + kc * 8;
    int ce = 0, cmt = 0, cnt_n = 0, cnv = 1, ne = 0, nmt = 0, nnt = 0, nnv = 1; int cpair[4], npair[4];
    int* tpre = (int*)(lds + 2 * G_STAGE + 2048); int* tcnt = tpre + 64;
    __syncthreads();
    if (tid < 32) tcnt[tid] = cnt[tid];
    __syncthreads();
    if (tid == 0) { int a = 0; for (int i = 0; i < 32; ++i) { tpre[i] = a; a += ((tcnt[i] + GBM - 1) / GBM) * NTN; } tpre[32] = a; }
    __syncthreads();
#define MS_LOOKUP(seq, E, MT, NT, NV, PAIR, OK) { const int it_ = blockIdx.x + (seq) * gridDim.x; const int lo_ = tpre[lane & 31], hi_ = tpre[(lane & 31) + 1]; \
        const unsigned long long m_ = WAVE_BALLOT(it_ >= lo_ && it_ < hi_); OK = (m_ != 0ull); \
        if (OK) { E = WAVE_FIRST((int)__builtin_ctzll(m_)); const int t_ = it_ - WAVE_FIRST(tpre[E]); MT = t_ / NTN; NT = t_ % NTN; NV = WAVE_FIRST(tcnt[E]); const int* lst_ = p.mlist() + (size_t)E * LCAP; _Pragma("unroll") for (int i = 0; i < 4; ++i) { const int gr_ = MT * GBM + lr + 32 * i; PAIR[i] = lst_[gr_ < NV ? gr_ : NV - 1]; } } }
#define MS_STASH(seq, PAIR) { if (kc == 0) { const int lr_ = TIDX >> 3;   _Pragma("unroll") for (int i = 0; i < 4; ++i) { u32x2 ent_; ent_.x = (unsigned)PAIR[i]; ent_.y = HID ? 0u : __builtin_bit_cast(unsigned, p.ew()[PAIR[i]]); stash[((seq) & 1) * 128 + lr_ + 32 * i] = ent_; } } }
#define MS_GLOAD(PAIR, WB, ks, RA, RB) { const int k0_ = (ks) * GBK; _Pragma("unroll") for (int i = 0; i < 4; ++i) { RA[i] = *(const u32x4*)(Abase + (size_t)(PAIR[i] >> RSH) * LDA + kc * 8 + k0_); RB[i] = *(const u32x4*)((WB) + wofs0 + i * (32 * K) + k0_); } }
#define MS_LSTORE(st, RA, RB) { unsigned char* sb_ = lds + (st) * G_STAGE; _Pragma("unroll") for (int i = 0; i < 4; ++i) { *(u32x4*)(sb_ + soff0 + i * 4096) = RA[i]; *(u32x4*)(sb_ + 16384 + soff0 + i * 4096) = RB[i]; } }
#define MS_COMPUTE(st) { const unsigned char* sa = lds + (st) * G_STAGE; const unsigned char* sb = sa + 16384; \
        _Pragma("unroll") for (int ks = 0; ks < 2; ++ks) { bf16x8 af[4], bfr[4]; const int ch = ks * 4 + fq; \
            _Pragma("unroll") for (int i = 0; i < 4; ++i) { const int ra_ = wm * 64 + i * 16 + fr, rb_ = wn * 64 + i * 16 + fr; \
                af[i] = *(const bf16x8*)(sa + ra_ * 128 + ((ch ^ ((ra_ >> 1) & 7)) << 4)); bfr[i] = *(const bf16x8*)(sb + rb_ * 128 + ((ch ^ ((rb_ >> 1) & 7)) << 4)); } \
            SETPRIO(1); _Pragma("unroll") for (int mi = 0; mi < 4; ++mi) _Pragma("unroll") for (int ni = 0; ni < 4; ++ni) acc[mi][ni] = MFMA16(bfr[ni], af[mi], acc[mi][ni]); SETPRIO(0); } }
    __syncthreads();
    bool has; MS_LOOKUP(0, ce, cmt, cnt_n, cnv, cpair, has)
    if (!has) return;
    MS_STASH(0, cpair)
    const bf16_t* cW = Wall + (size_t)ce * WEXP + (size_t)cnt_n * GBN * K;
    u32x4 ra[4], rb[4], ra2[4], rb2[4];
    MS_GLOAD(cpair, cW, 0, ra, rb) MS_LSTORE(0, ra, rb)
    MS_GLOAD(cpair, cW, 1, ra, rb) MS_GLOAD(cpair, cW, 2, ra2, rb2)
    __syncthreads();
    for (int seq = 0;; ++seq) {
        bool hasn; MS_LOOKUP(seq + 1, ne, nmt, nnt, nnv, npair, hasn)
        const bf16_t* nW = Wall + (size_t)ne * WEXP + (size_t)nnt * GBN * K;
        f32x4 acc[4][4];
#pragma unroll
        for (int mi = 0; mi < 4; ++mi)
#pragma unroll
            for (int ni = 0; ni < 4; ++ni) acc[mi][ni] = (f32x4){0.f, 0.f, 0.f, 0.f};
#pragma unroll 1
        for (int kt = 0; kt < NK; kt += 2) {
            MS_LSTORE(1, ra, rb)
            if (kt + 3 < NK) MS_GLOAD(cpair, cW, kt + 3, ra, rb) else if (hasn) MS_GLOAD(npair, nW, kt + 3 - NK, ra, rb)
            MS_COMPUTE(0)
            __syncthreads();
            if (kt + 2 < NK || hasn) MS_LSTORE(0, ra2, rb2)
            if (kt + 4 < NK) MS_GLOAD(cpair, cW, kt + 4, ra2, rb2) else if (hasn) MS_GLOAD(npair, nW, kt + 4 - NK, ra2, rb2)
            MS_COMPUTE(1)
            __syncthreads();
        }
        if (hasn) MS_STASH(seq + 1, npair)
        { const u32x2* st = stash + (seq & 1) * 128; const int nb = cnt_n * GBN + wn * 64;
#pragma unroll
          for (int mi = 0; mi < 4; ++mi) { const int lrow = wm * 64 + mi * 16 + fr; const bool valid = cmt * GBM + lrow < cnv; const u32x2 ent = st[lrow]; const int pair = (int)ent.x;
              if (HID) {
                  u32x2 hw2[2];
#pragma unroll
                  for (int ni = 0; ni < 2; ++ni) { const f32x4 g = acc[mi][ni], u = acc[mi][ni + 2]; f32x4 hv;
#pragma unroll
                      for (int r = 0; r < 4; ++r) hv[r] = fast_silu(g[r]) * u[r];
                      hw2[ni] = pack4bf(hv); }
                  const u32x4 w16 = pair16(hw2[0], hw2[1]);
                  if (valid) *(u32x4*)(p.hid() + (size_t)pair * 256 + cnt_n * 64 + wn * 32 + pair16_col(fq)) = w16;
              } else {
                  const unsigned wbits = ent.y; const float w = __builtin_bit_cast(float, wbits);
                  const float* m5 = modp(p, layer, modrow(pair >> 1), 5); bf16_t* yr = p.ys() + (size_t)pair * D;
#pragma unroll
                  for (int np = 0; np < 2; ++np) { const int col = nb + np * 32 + fq * 4;
                      const u32x4 w16 = pair16(pack4bf(*(const f32x4*)(m5 + col) * acc[mi][2 * np] * w), pack4bf(*(const f32x4*)(m5 + col + 16) * acc[mi][2 * np + 1] * w));
                      if (valid) *(u32x4*)(yr + nb + np * 32 + pair16_col(fq)) = w16; }
              } } }
        if (!hasn) break;
        ce = ne; cmt = nmt; cnt_n = nnt; cnv = nnv; cW = nW;
#pragma unroll
        for (int i = 0; i < 4; ++i) cpair[i] = npair[i];
    }
#undef MS_LOOKUP
#undef MS_STASH
#undef MS_GLOAD
#undef MS_LSTORE
#undef MS_COMPUTE
}
DEVNI void bk_moe_hidden(const Params& p, unsigned char* lds, int layer) {
    const int* cnt = p.mcnt() + layer * 32;
    for (int it = blockIdx.x;; it += gridDim.x) {
        int e, mt, nt; if (!moe_item(cnt, it, 4, e, mt, nt)) break;
        const int* lst = p.mlist() + (size_t)e * LCAP; const int nv = cnt[e];
        GemmSrcA A = plainA(p.xn(), D); A.rowidx = lst; A.nvalid = nv; A.rowshift = 1;
        gemm_tile<true>(lds, A, mt * GBM, p.wt_gu() + (size_t)e * 512 * D, D, nt * GBN, D, [&](f32x4 (&acc)[4][4], int mb, int nb, int fr, int fq) {
            const int wn = (nb / 64) & 1;
#pragma unroll
            for (int mi = 0; mi < 4; ++mi) { const int li = mb + mi * 16 + fr; if (li < nv) { const int pair = lst[li];
#pragma unroll
                for (int ni = 0; ni < 2; ++ni) { const f32x4 g = acc[mi][ni], u = acc[mi][ni + 2]; f32x4 hv;
#pragma unroll
                    for (int r = 0; r < 4; ++r) hv[r] = fast_silu(g[r]) * u[r];
                    *(u32x2*)(p.hid() + (size_t)pair * 256 + nt * 64 + wn * 32 + ni * 16 + fq * 4) = pack4bf(hv); } } }
        });
    }
}
DEVNI void bk_moe_down(const Params& p, unsigned char* lds, int layer) {
    const int* cnt = p.mcnt() + layer * 32;
    for (int it = blockIdx.x;; it += gridDim.x) {
        int e, mt, nt; if (!moe_item(cnt, it, 8, e, mt, nt)) break;
        const int* lst = p.mlist() + (size_t)e * LCAP; const int nv = cnt[e];
        GemmSrcA A = plainA(p.hid(), 256); A.rowidx = lst; A.nvalid = nv; A.rowshift = 0;
        gemm_tile<true>(lds, A, mt * GBM, p.wt_dn() + (size_t)e * D * 256, 256, nt * GBN, 256, [&](f32x4 (&acc)[4][4], int mb, int nb, int fr, int fq) {
#pragma unroll
            for (int mi = 0; mi < 4; ++mi) { const int li = mb + mi * 16 + fr; if (li < nv) { const int pair = lst[li], tk = pair >> 1; const float w = p.ew()[pair];
                const float* m5 = modp(p, layer, modrow(tk), 5); bf16_t* yr = p.ys() + (size_t)pair * D;
#pragma unroll
                for (int ni = 0; ni < 4; ++ni) { const int col = nb + ni * 16 + fq * 4; *(u32x2*)(yr + col) = pack4bf(*(const f32x4*)(m5 + col) * acc[mi][ni] * w); } } }
        });
    }
}


constexpr float QSCALE = 0.07216878364870322f * 1.4426950408889634f;
DEVNI void bk_uq_rope(const Params& p, unsigned char* lds) {
    const GemmSrcA A = plainA(p.cq() + (size_t)TC * 384, 384); constexpr int NTM = TL / GBM2, NTN = 1536 / GBN;
    for (int it = blockIdx.x; it < NTM * NTN; it += gridDim.x) {
        const int mt = it % NTM, nt = it / NTM;
        gemm_tile2<true>(lds, A, mt * GBM2, p.wt_uq(), 384, nt * GBN, 384, [&](f32x4 (&acc)[4][4], int mb, int nb, int fr, int fq) {
            const bool rope = ((nb / 64) % 3) == 2;
#pragma unroll
            for (int mi = 0; mi < 4; ++mi) { const int row = mb + mi * 16 + fr, t = row % NL;
                if (rope) {
#pragma unroll
                    for (int hf = 0; hf < 2; ++hf) { const int pos = hf ? (t % 64) : (t / 64);
                        const f32x4 ra = *(const f32x4*)(p.ropetab() + (pos * 16 + fq * 4) * 2), rb4 = *(const f32x4*)(p.ropetab() + (pos * 16 + fq * 4) * 2 + 4); const float cs4[4] = {ra[0], ra[2], rb4[0], rb4[2]}, sn4[4] = {ra[1], ra[3], rb4[1], rb4[3]};
#pragma unroll
                        for (int r = 0; r < 4; ++r) { const float cs = cs4[r], sn = sn4[r];
                            const float t1 = acc[mi][2 * hf][r], t2 = acc[mi][2 * hf + 1][r]; acc[mi][2 * hf][r] = t1 * cs - t2 * sn; acc[mi][2 * hf + 1][r] = t2 * cs + t1 * sn; } } }
#pragma unroll
                for (int np = 0; np < 2; ++np) st16_pair(p.qb() + (size_t)row * 1536 + nb + np * 32, fq, pack4bf(acc[mi][2 * np] * QSCALE), pack4bf(acc[mi][2 * np + 1] * QSCALE)); }
        });
    }
}
DEVNI void bk_ukv_split(const Params& p, unsigned char* lds) {
    const GemmSrcA A = plainA(p.ckv(), 256); constexpr int NTM = T / GBM2, NTN = 2048 / GBN;
    for (int it = blockIdx.x; it < NTM * NTN; it += gridDim.x) {
        const int mt = it % NTM, nt = it / NTM, h = nt >> 1;
        if ((nt & 1) == 0) {
            gemm_tile2<true>(lds, A, mt * GBM2, p.wt_ukv(), 256, nt * GBN, 256, [&](f32x4 (&acc)[4][4], int mb, int nb, int fr, int fq) {
#pragma unroll
                for (int mi = 0; mi < 4; ++mi)
#pragma unroll
                    for (int np = 0; np < 2; ++np) { const int row = mb + mi * 16 + fr, c0 = (nb & 127) + np * 32; st16_pair(p.kn() + (size_t)row * 1024 + h * 128 + c0, fq, pack4bf(acc[mi][2 * np]), pack4bf(acc[mi][2 * np + 1])); }
            });
        } else {
            gemm_tile2<false>(lds, A, mt * GBM2, p.wt_ukv(), 256, nt * GBN, 256, [&](f32x4 (&acc)[4][4], int mb, int nb, int fr, int fq) {
#pragma unroll
                for (int mp = 0; mp < 2; ++mp) { const int tk = mb + mp * 32; int b, key; if (tk < TC) { b = tk / NC; key = tk % NC; } else { b = (tk - TC) / NL; key = NC + (tk - TC) % NL; }
#pragma unroll
                    for (int ni = 0; ni < 4; ++ni) { const int d = (nb & 127) + ni * 16 + fr; st16_pair(p.vT() + ((size_t)(b * 8 + h) * 128 + d) * SQ + key, fq, pack4bf(acc[2 * mp][ni]), pack4bf(acc[2 * mp + 1][ni])); } }
            });
        }
    }
}
constexpr int FA_KROW = 400, FA_VROW = 72, FA_KBYTES = 32 * FA_KROW, FA_VBYTES = 128 * FA_VROW, FA_VOFF = 3 * FA_KBYTES;
static_assert(FA_VOFF + 2 * FA_VBYTES <= LDS_BYTES, "attention LDS");
DEVNI void bk_attn(const Params& p, unsigned char* lds) {
    const int tid = TIDX, lane = tid & 63, wave = tid >> 6, lq = lane & 31, hh = lane >> 5;
    constexpr int NQT = NL / 128, NKT = SQ / 32;
    for (int it = blockIdx.x; it < NB * 8 * NQT; it += gridDim.x) {
        const int qt = it % NQT, h = (it / NQT) % 8, b = it / (NQT * 8);
        bf16x8 qf[12];
        { const bf16_t* qp = p.qb() + ((size_t)(b * NL + qt * 128 + wave * 32 + lq) * 8 + h) * 192 + 8 * hh;
#pragma unroll
          for (int ks = 0; ks < 12; ++ks) qf[ks] = *(const bf16x8*)(qp + ks * 16); }
        f32x16 oT[4];
#pragma unroll
        for (int dt = 0; dt < 4; ++dt)
#pragma unroll
            for (int r = 0; r < 16; ++r) oT[dt][r] = 0.f;
        float mrun = -1.0e30f, lrun = 0.f;
        u32x4 kreg[3], vreg[2];
        const bf16_t* vbase = p.vT() + (size_t)(b * 8 + h) * 128 * SQ;
#define FA_GLOADK(kt) { const int key0_ = (kt) * 32; \
            _Pragma("unroll") for (int i = 0; i < 3; ++i) { const int c_ = tid + i * 256, row_ = c_ / 24, ch_ = c_ % 24; const int tok_ = key_tok(b, key0_ + row_); \
                kreg[i] = ch_ < 16 ? *(const u32x4*)(p.kn() + (size_t)tok_ * 1024 + h * 128 + ch_ * 8) : *(const u32x4*)(p.kpe() + (size_t)tok_ * 64 + (ch_ - 16) * 8); } }
#define FA_GLOADV(kt) { const int key0_ = (kt) * 32; \
            _Pragma("unroll") for (int i = 0; i < 2; ++i) { const int c_ = tid + i * 256, d_ = c_ >> 2, kc_ = c_ & 3; vreg[i] = *(const u32x4*)(vbase + (size_t)d_ * SQ + key0_ + kc_ * 8); } }
#define FA_LSTOREK(kb) { unsigned char* sb_ = lds + (kb) * FA_KBYTES; \
            _Pragma("unroll") for (int i = 0; i < 3; ++i) { const int c_ = tid + i * 256, row_ = c_ / 24, ch_ = c_ % 24; *(u32x4*)(sb_ + row_ * FA_KROW + ch_ * 16) = kreg[i]; } }
#define FA_LSTOREV(vb) { unsigned char* sb_ = lds + FA_VOFF + (vb) * FA_VBYTES; \
            _Pragma("unroll") for (int i = 0; i < 2; ++i) { const int c_ = tid + i * 256, d_ = c_ >> 2, kc_ = c_ & 3; u32x2 lo_, hi_; lo_.x = vreg[i].x; lo_.y = vreg[i].y; hi_.x = vreg[i].z; hi_.y = vreg[i].w; \
                *(u32x2*)(sb_ + d_ * FA_VROW + kc_ * 16) = lo_; *(u32x2*)(sb_ + d_ * FA_VROW + kc_ * 16 + 8) = hi_; } }
#define FA_QK(kb, ST) { const unsigned char* sk_ = lds + (kb) * FA_KBYTES; _Pragma("unroll") for (int r = 0; r < 16; ++r) ST[r] = 0.f; \
            _Pragma("unroll") for (int ks = 0; ks < 12; ++ks) { const bf16x8 kf = *(const bf16x8*)(sk_ + lq * FA_KROW + (ks * 2 + hh) * 16); ST = MFMA32(kf, qf[ks], ST); } }
        __syncthreads();
        FA_GLOADK(0) FA_GLOADV(0) FA_LSTOREK(0) FA_LSTOREV(0)
        FA_GLOADK(1) FA_LSTOREK(1)
        __syncthreads();
        f32x16 sT;
        FA_QK(0, sT)
        int kb1 = 1, kb2 = 2;
        for (int kt = 0; kt < NKT; ++kt) {
            if (kt + 2 < NKT) FA_GLOADK(kt + 2)
            if (kt + 1 < NKT) FA_GLOADV(kt + 1)
            const unsigned char* sv = lds + FA_VOFF + (kt & 1) * FA_VBYTES;
            float mx = sT[0];
#pragma unroll
            for (int r = 1; r < 16; ++r) mx = fmaxf(mx, sT[r]);
            mx = MAX_XOR32(mx);
            if (WAVE_ANY(mx > mrun + 8.0f)) {
                const float mnew = fmaxf(mrun, mx), alpha = FAST_EXP2(mrun - mnew); mrun = mnew; lrun *= alpha;
#pragma unroll
                for (int dt = 0; dt < 4; ++dt) oT[dt] = oT[dt] * alpha;
            }
            f32x16 sN;
            SETPRIO(1);
            FA_QK(kb1, sN)
            float ps = 0.f;
#pragma unroll
            for (int r = 0; r < 16; ++r) { const float e = FAST_EXP2(sT[r] - mrun); sT[r] = e; ps += e; }
            lrun += ps;
#pragma unroll
            for (int s2 = 0; s2 < 2; ++s2) {
                u32x4 pw; pw.x = pack2bf(sT[8 * s2], sT[8 * s2 + 1]); pw.y = pack2bf(sT[8 * s2 + 2], sT[8 * s2 + 3]); pw.z = pack2bf(sT[8 * s2 + 4], sT[8 * s2 + 5]); pw.w = pack2bf(sT[8 * s2 + 6], sT[8 * s2 + 7]);
                const bf16x8 pf = __builtin_bit_cast(bf16x8, pw);
#pragma unroll
                for (int dt = 0; dt < 4; ++dt) { const unsigned char* vp = sv + (dt * 32 + lq) * FA_VROW + (16 * s2 + 4 * hh) * 2;
                    const u32x2 lo = *(const u32x2*)vp, hi = *(const u32x2*)(vp + 16);
                    u32x4 w; w.x = lo.x; w.y = lo.y; w.z = hi.x; w.w = hi.y; oT[dt] = MFMA32(__builtin_bit_cast(bf16x8, w), pf, oT[dt]); }
            }
            SETPRIO(0);
            if (kt + 2 < NKT) FA_LSTOREK(kb2)
            if (kt + 1 < NKT) FA_LSTOREV((kt + 1) & 1)
            __syncthreads();
            sT = sN;
            kb1 = kb2; kb2 = (kb2 == 2) ? 0 : kb2 + 1;
        }
#undef FA_GLOADK
#undef FA_GLOADV
#undef FA_LSTOREK
#undef FA_LSTOREV
#undef FA_QK
        const float ltot = SUM_XOR32(lrun), inv = 1.0f / ltot;
        bf16_t* op = p.ao() + (size_t)(b * NL + qt * 128 + wave * 32 + lq) * D + h * 128;
#pragma unroll
        for (int dt = 0; dt < 4; ++dt)
#pragma unroll
            for (int gp2 = 0; gp2 < 2; ++gp2) { u32x2 pk[2];
#pragma unroll
                for (int e = 0; e < 2; ++e) { const int g4 = 2 * gp2 + e; f32x4 v; v[0] = oT[dt][4 * g4] * inv; v[1] = oT[dt][4 * g4 + 1] * inv; v[2] = oT[dt][4 * g4 + 2] * inv; v[3] = oT[dt][4 * g4 + 3] * inv; pk[e] = pack4bf(v); }
                st16_pair32(op + dt * 32 + 16 * gp2, hh, pk[0], pk[1]); }
    }
}
DEVFN void unpack8(const u32x4 w, float* f);
static_assert(NC % RCH == 0 && NL % RCH == 0, "chunking");
static_assert(NRET % 32 == 0 && EVEN_IN % 32 == 0 && SHIFT_W % 8 == 0, "tile-pair stores");
DEVFN int chunk_tok0(int b, int tc) { return tc < NCC ? b * NC + tc * RCH : TC + b * NL + (tc - NCC) * RCH; }
DEVFN float ret_lg2(int h) { return log2f(1.0f - exp2f(-5.0f - (float)h)); }
DEVFN bf16_t* retS_ptr(const Params& p, int b, int h, int dir, int tc) { return p.retS() + ((((size_t)(b * 4 + h) * 2 + dir) * NCH + tc) * 128) * 64; }
DEVFN int r_ktoff(int dk, int tok) { return dk * 256 + ((((tok >> 3) ^ (dk & 15)) << 4) | ((tok & 7) << 1)); }
DEVFN int r_vtoff(int dv, int tok) { return 32768 + dv * 256 + ((((tok >> 2) ^ (dv & 31)) << 3) | ((tok & 3) << 1)); }
DEVNI void bk_ret_delta(const Params& p, unsigned char* lds) {
    const int tid = TIDX, lane = tid & 63, wave = tid >> 6, lq = lane & 31, hh = lane >> 5;
    for (int it = blockIdx.x; it < NB * 4 * NCH; it += gridDim.x) {
        const int tc = it % NCH, h = (it / NCH) % 4, b = it / (NCH * 4); const int tok0 = chunk_tok0(b, tc); const float lg = ret_lg2(h);
        __syncthreads();
        { const int j = tid & 127, part = tid >> 7; const bf16_t* row = p.pret() + (size_t)(tok0 + j) * NRET;
          const float df = exp2f(lg * (float)(127 - j)), db = exp2f(lg * (float)j);
          u32x4 kw[4], vw[8];
#pragma unroll
          for (int q = 0; q < 4; ++q) kw[q] = *(const u32x4*)(row + 256 + h * 64 + part * 32 + q * 8);
#pragma unroll
          for (int q = 0; q < 8; ++q) vw[q] = *(const u32x4*)(row + 512 + h * 128 + part * 64 + q * 8);
#pragma unroll
          for (int q = 0; q < 4; ++q) { float kf[8]; unpack8(kw[q], kf);
#pragma unroll
              for (int e = 0; e < 8; ++e) { const int c = part * 32 + q * 8 + e; *(bf16_t*)(lds + r_ktoff(c, j)) = f2bf(kf[e] * df); *(bf16_t*)(lds + 16384 + r_ktoff(c, j)) = f2bf(kf[e] * db); } }
#pragma unroll
          for (int q = 0; q < 8; ++q) { const unsigned wd[4] = {vw[q].x, vw[q].y, vw[q].z, vw[q].w};
#pragma unroll
              for (int e = 0; e < 4; ++e) { const int c = part * 64 + q * 8 + 2 * e; *(bf16_t*)(lds + r_vtoff(c, j)) = (bf16_t)(wd[e] & 0xffffu); *(bf16_t*)(lds + r_vtoff(c + 1, j)) = (bf16_t)(wd[e] >> 16); } } }
        __syncthreads();
#pragma unroll
        for (int dir = 0; dir < 2; ++dir) {
            f32x16 acc[2];
#pragma unroll
            for (int mt = 0; mt < 2; ++mt)
#pragma unroll
                for (int r = 0; r < 16; ++r) acc[mt][r] = 0.f;
#pragma unroll
            for (int ks = 0; ks < 8; ++ks) {
                const int t0 = 16 * ks + 8 * hh, dv = wave * 32 + lq;
                const u32x2 v0 = *(const u32x2*)(lds + r_vtoff(dv, t0)), v1 = *(const u32x2*)(lds + r_vtoff(dv, t0 + 4));
                u32x4 vw; vw.x = v0.x; vw.y = v0.y; vw.z = v1.x; vw.w = v1.y; const bf16x8 vf = __builtin_bit_cast(bf16x8, vw);
#pragma unroll
                for (int mt = 0; mt < 2; ++mt) { const bf16x8 kf = *(const bf16x8*)(lds + dir * 16384 + r_ktoff(mt * 32 + lq, t0)); acc[mt] = MFMA32(kf, vf, acc[mt]); }
            }
            bf16_t* dst = retS_ptr(p, b, h, dir, tc) + (size_t)(wave * 32 + lq) * 64;
#pragma unroll
            for (int mt = 0; mt < 2; ++mt)
#pragma unroll
                for (int gp2 = 0; gp2 < 2; ++gp2) { u32x2 pk[2];
#pragma unroll
                    for (int e = 0; e < 2; ++e) { const int g4 = 2 * gp2 + e; f32x4 v; v[0] = acc[mt][4 * g4]; v[1] = acc[mt][4 * g4 + 1]; v[2] = acc[mt][4 * g4 + 2]; v[3] = acc[mt][4 * g4 + 3]; pk[e] = pack4bf(v); }
                    st16_pair32(dst + mt * 32 + 16 * gp2, hh, pk[0], pk[1]); }
        }
    }
}
DEVFN int ret_order(int dir, int j) { return dir == 0 ? j : (j < NCC ? NCC - 1 - j : NCC + (NCH - 1 - j)); }
DEVNI void bk_ret_prefix(const Params& p, unsigned char* lds) {
    (void)lds;
    for (int it = blockIdx.x; it < NB * 4 * 2 * 8; it += gridDim.x) {
        const int sl = it % 8, dir = (it / 8) % 2, h = (it / 16) % 4, b = it / 64; const float g128 = exp2f(ret_lg2(h) * 128.f);
        const int e0 = sl * 1024 + threadIdx.x * 4; f32x4 st = (f32x4){0.f, 0.f, 0.f, 0.f};
        u32x2 dws[NCH];
#pragma unroll
        for (int j = 0; j < NCH; ++j) dws[j] = *(const u32x2*)(retS_ptr(p, b, h, dir, ret_order(dir, j)) + e0);
#pragma unroll
        for (int j = 0; j < NCH; ++j) { bf16_t* q = retS_ptr(p, b, h, dir, ret_order(dir, j)) + e0; const u32x2 dw = dws[j];
            f32x4 d; d[0] = __builtin_bit_cast(float, dw.x << 16); d[1] = __builtin_bit_cast(float, dw.x & 0xffff0000u); d[2] = __builtin_bit_cast(float, dw.y << 16); d[3] = __builtin_bit_cast(float, dw.y & 0xffff0000u);
            *(u32x2*)q = pack4bf(st); st = st * g128 + d; }
    }
}
DEVNI void bk_ret_out(const Params& p, unsigned char* lds) {
    const int tid = TIDX, lane = tid & 63, wave = tid >> 6, lq = lane & 31, hh = lane >> 5;
    for (int it = blockIdx.x; it < NB * 4 * NCH; it += gridDim.x) {
        const int tc = it % NCH, h = (it / NCH) % 4, b = it / (NCH * 4); const int tok0 = chunk_tok0(b, tc); const float lg = ret_lg2(h);
        __syncthreads();
        { for (int c = tid; c < 1024; c += 256) { const int row = c >> 3, ch = c & 7; *(u32x4*)(lds + row * 128 + ((ch ^ ((row >> 1) & 7)) << 4)) = *(const u32x4*)(p.pret() + (size_t)(tok0 + row) * NRET + 256 + h * 64 + ch * 8); }
          const int j = tid & 127, part = tid >> 7; const bf16_t* row = p.pret() + (size_t)(tok0 + j) * NRET;
          u32x4 vw[8];
#pragma unroll
          for (int q = 0; q < 8; ++q) vw[q] = *(const u32x4*)(row + 512 + h * 128 + part * 64 + q * 8);
#pragma unroll
          for (int q = 0; q < 8; ++q) { const unsigned wd[4] = {vw[q].x, vw[q].y, vw[q].z, vw[q].w};
#pragma unroll
              for (int e = 0; e < 4; ++e) { const int c = part * 64 + q * 8 + 2 * e; *(bf16_t*)(lds + r_vtoff(c, j)) = (bf16_t)(wd[e] & 0xffffu); *(bf16_t*)(lds + r_vtoff(c + 1, j)) = (bf16_t)(wd[e] >> 16); } } }
        const int qi = wave * 32 + lq; bf16x8 qf[4];
        { const bf16_t* qp = p.pret() + (size_t)(tok0 + qi) * NRET + h * 64 + 8 * hh;
#pragma unroll
          for (int ks = 0; ks < 4; ++ks) qf[ks] = *(const bf16x8*)(qp + ks * 16); }
        bf16x8 sf[16];
#define R2_LOADS(dir_) { const bf16_t* S_ = retS_ptr(p, b, h, (dir_), tc); _Pragma("unroll") for (int dt = 0; dt < 4; ++dt) _Pragma("unroll") for (int ks = 0; ks < 4; ++ks) sf[dt * 4 + ks] = *(const bf16x8*)(S_ + (size_t)(dt * 32 + lq) * 64 + ks * 16 + 8 * hh); \
            _Pragma("unroll") for (int q4 = 0; q4 < 4; ++q4) OPAQUE4V(sf[4 * q4], sf[4 * q4 + 1], sf[4 * q4 + 2], sf[4 * q4 + 3]) }
#define R2_CROSS(dir_) { const float sc = exp2f(lg * (float)((dir_) == 0 ? qi + 1 : 128 - qi)); _Pragma("unroll") for (int dt = 0; dt < 4; ++dt) { f32x16 x; _Pragma("unroll") for (int r = 0; r < 16; ++r) x[r] = 0.f; \
            _Pragma("unroll") for (int ks = 0; ks < 4; ++ks) x = MFMA32(sf[dt * 4 + ks], qf[ks], x); oT[dt] = oT[dt] + x * sc; } }
        R2_LOADS(0)
        __syncthreads();
        f32x16 oT[4];
#pragma unroll
        for (int dt = 0; dt < 4; ++dt)
#pragma unroll
            for (int r = 0; r < 16; ++r) oT[dt][r] = 0.f;
        R2_CROSS(0)
#pragma unroll 1
        for (int kb = 0; kb < 4; ++kb) {
            f32x16 sT;
#pragma unroll
            for (int r = 0; r < 16; ++r) sT[r] = 0.f;
#pragma unroll
            for (int ks = 0; ks < 4; ++ks) { const int row = kb * 32 + lq, ch = ks * 2 + hh; const bf16x8 kf = *(const bf16x8*)(lds + row * 128 + ((ch ^ ((row >> 1) & 7)) << 4)); sT = MFMA32(kf, qf[ks], sT); }
#pragma unroll
            for (int r = 0; r < 16; ++r) { const int key = kb * 32 + (r & 3) + 8 * (r >> 2) + 4 * hh; const int dd = key > qi ? key - qi : qi - key; sT[r] *= FAST_EXP2(lg * (float)dd); }
#pragma unroll
            for (int s2 = 0; s2 < 2; ++s2) {
                u32x4 pw; pw.x = pack2bf(sT[8 * s2], sT[8 * s2 + 1]); pw.y = pack2bf(sT[8 * s2 + 2], sT[8 * s2 + 3]); pw.z = pack2bf(sT[8 * s2 + 4], sT[8 * s2 + 5]); pw.w = pack2bf(sT[8 * s2 + 6], sT[8 * s2 + 7]);
                const bf16x8 pf = __builtin_bit_cast(bf16x8, pw);
                const int t0 = kb * 32 + 16 * s2 + 4 * hh;
#pragma unroll
                for (int dt = 0; dt < 4; ++dt) { const int dv = dt * 32 + lq; const u32x2 v0 = *(const u32x2*)(lds + r_vtoff(dv, t0)), v1 = *(const u32x2*)(lds + r_vtoff(dv, t0 + 8));
                    u32x4 vw; vw.x = v0.x; vw.y = v0.y; vw.z = v1.x; vw.w = v1.y; oT[dt] = MFMA32(__builtin_bit_cast(bf16x8, vw), pf, oT[dt]); }
            }
        }
        R2_LOADS(1)
        R2_CROSS(1)
#undef R2_LOADS
#undef R2_CROSS
        u32x2 gwv[16];
        { const bf16_t* gp_ = p.pret() + (size_t)(tok0 + qi) * NRET + 1024 + h * 128;
#pragma unroll
          for (int dt = 0; dt < 4; ++dt)
#pragma unroll
              for (int g4 = 0; g4 < 4; ++g4) gwv[dt * 4 + g4] = *(const u32x2*)(gp_ + dt * 32 + 8 * g4 + 4 * hh);
#pragma unroll
          for (int q4 = 0; q4 < 4; ++q4) OPAQUE4V(gwv[4 * q4], gwv[4 * q4 + 1], gwv[4 * q4 + 2], gwv[4 * q4 + 3]) }
        float ss = 0.f;
#pragma unroll
        for (int dt = 0; dt < 4; ++dt)
#pragma unroll
            for (int r = 0; r < 16; ++r) ss += oT[dt][r] * oT[dt][r];
        ss = SUM_XOR32(ss);
        const float rs = rsqrtf(ss / 128.f + EPS);
        bf16_t* op = p.mixr() + (size_t)(tok0 + qi) * 512 + h * 128;
#pragma unroll
        for (int dt = 0; dt < 4; ++dt)
#pragma unroll
            for (int gp2 = 0; gp2 < 2; ++gp2) { u32x2 pk[2];
#pragma unroll
                for (int e = 0; e < 2; ++e) { const int g4 = 2 * gp2 + e; const u32x2 gw = gwv[dt * 4 + g4];
                    f32x4 v; v[0] = oT[dt][4 * g4] * rs * fast_silu(bf2f((bf16_t)(gw.x & 0xffff))); v[1] = oT[dt][4 * g4 + 1] * rs * fast_silu(bf2f((bf16_t)(gw.x >> 16)));
                    v[2] = oT[dt][4 * g4 + 2] * rs * fast_silu(bf2f((bf16_t)(gw.y & 0xffff))); v[3] = oT[dt][4 * g4 + 3] * rs * fast_silu(bf2f((bf16_t)(gw.y >> 16)));
                    pk[e] = pack4bf(v); }
                st16_pair32(op + dt * 32 + 16 * gp2, hh, pk[0], pk[1]); }
    }
}


#ifndef HOST_EMU
template <int CTRL> DEVFN float dpp_f(float v) { return __builtin_bit_cast(float, __builtin_amdgcn_update_dpp(0, __builtin_bit_cast(int, v), CTRL, 0xf, 0xf, true)); }
#define RED8(v) { v += dpp_f<0xB1>(v); v += dpp_f<0x4E>(v); v += dpp_f<0x141>(v); }
#define QUAD_XOR1(v) dpp_f<0xB1>(v)
#define QUAD_XOR2(v) dpp_f<0x4E>(v)
#define QUAD_BCAST(v, k) ((k) == 0 ? dpp_f<0x00>(v) : (k) == 1 ? dpp_f<0x55>(v) : (k) == 2 ? dpp_f<0xAA>(v) : dpp_f<0xFF>(v))
#else
#define RED8(v) { v += SHFL_XOR(v, 1); v += SHFL_XOR(v, 2); v += SHFL_XOR(v, 4); }
#define QUAD_XOR1(v) SHFL_XOR(v, 1)
#define QUAD_XOR2(v) SHFL_XOR(v, 2)
#define QUAD_BCAST(v, k) emu_shfl(v, (emu_lane() & ~3) | (k))
#endif
#ifndef HOST_EMU
#define RED16(v) { RED8(v) v += dpp_f<0x140>(v); }
#else
#define RED16(v) { RED8(v) v += SHFL_XOR(v, 8); }
#endif
#define RED64(v) { RED16(v) v += SHFL_XOR(v, 16); v = SUM_XOR32(v); }
constexpr int SCH = 16, SC_IN = (5 * SCH * 64 + SCH * 16) * 4, SC_STAGE = SC_IN, SC_YOFF = 2 * SC_IN, SC_YBYTES = SCH * 16 * 16 * 4;
static_assert(SC_YOFF + SC_YBYTES <= LDS_BYTES, "scan LDS");
struct ScanIn { f32x4 kk, r, w, a, t; float vt; };
DEVFN void scan_load(ScanIn& x, const float* sb, int st, int kc, int vrow) {
    const float* q = sb + st * 64 + kc * 4;
    x.kk = *(const f32x4*)(q); x.r = *(const f32x4*)(q + SCH * 64); x.w = *(const f32x4*)(q + 2 * SCH * 64); x.a = *(const f32x4*)(q + 3 * SCH * 64); x.t = *(const f32x4*)(q + 4 * SCH * 64);
    x.vt = sb[5 * SCH * 64 + st * 16 + vrow];
}
#define V2(v4, i) ((f32x2){(v4)[2 * (i)], (v4)[2 * (i) + 1]})
DEVFN float scan_step(f32x2 (&S)[2], const ScanIn& x) {
    f32x2 d = S[0] * V2(x.kk, 0); d = S[1] * V2(x.kk, 1) + d;
    float sa = d[0] + d[1];
    RED16(sa)
    const f32x2 vt2 = (f32x2){x.vt, x.vt}, nsa = (f32x2){-sa, -sa};
    S[0] = S[0] * V2(x.w, 0) + (nsa * V2(x.a, 0) + vt2 * V2(x.t, 0));
    S[1] = S[1] * V2(x.w, 1) + (nsa * V2(x.a, 1) + vt2 * V2(x.t, 1));
    f32x2 y = S[0] * V2(x.r, 0); y = S[1] * V2(x.r, 1) + y;
    return y[0] + y[1];
}
DEVNI void bk_rwkv_scan(const Params& p, unsigned char* lds) {
    const int tid = TIDX, lane = tid & 63, wave = tid >> 6, kc = lane & 15, vrow = wave * 4 + (lane >> 4);
    for (int it = blockIdx.x; it < NB * 8 * 2 * 4; it += gridDim.x) {
        const int quarter = it & 3, dir = (it >> 2) & 1, h = (it >> 3) & 7, b = it >> 6;
        const bf16_t* a_kk = p.fkk(); const bf16_t* a_r = p.fr(); const bf16_t* a_w = dir ? p.fomw1() : p.fomw0(); const bf16_t* a_a = dir ? p.fkka1() : p.fkka0(); const bf16_t* a_t = dir ? p.fkt1() : p.fkt0();
        bf16_t* yout = (dir ? p.ybw() : p.yf()) + h * 64 + quarter * 16 + (tid & 15);
        f32x2 S[2]; S[0] = (f32x2){0.f, 0.f}; S[1] = (f32x2){0.f, 0.f};
        u32x4 g0, g1, g2, gv; g0 = g1 = g2 = gv = (u32x4){0u, 0u, 0u, 0u};
        const int sst = (tid % 128) / 8, sch8 = (tid % 8) * 8;
        const bf16_t* pa0 = (tid < 128 ? a_kk : a_r) + h * 64 + sch8; const bf16_t* pa1 = (tid < 128 ? a_w : a_a) + h * 64 + sch8; const bf16_t* pa2 = a_t + h * 64 + sch8;
        const bf16_t* pv = p.fv() + h * 64 + quarter * 16 + (tid % 2) * 8; const int vst = (tid - 128) / 2;
#define SC_GLOAD(ch) { const int u0_ = (ch) * SCH; const size_t to_ = (size_t)scan_tok(b, dir, u0_ + sst) * 512; g0 = *(const u32x4*)(pa0 + to_); g1 = *(const u32x4*)(pa1 + to_); \
            if (tid < 128) g2 = *(const u32x4*)(pa2 + to_); else if (tid < 160) gv = *(const u32x4*)(pv + (size_t)scan_tok(b, dir, u0_ + vst) * 512); }
#define SC_CVT8(dst, srcv, isw) { const u32x4 w_ = (srcv); float* d_ = (dst); const float o_ = (isw) ? 1.0f : 0.0f, m_ = (isw) ? -1.0f : 1.0f; f32x4 lo_, hi_; \
            lo_[0] = o_ + m_ * __builtin_bit_cast(float, w_.x << 16); lo_[1] = o_ + m_ * __builtin_bit_cast(float, w_.x & 0xffff0000u); lo_[2] = o_ + m_ * __builtin_bit_cast(float, w_.y << 16); lo_[3] = o_ + m_ * __builtin_bit_cast(float, w_.y & 0xffff0000u); \
            hi_[0] = o_ + m_ * __builtin_bit_cast(float, w_.z << 16); hi_[1] = o_ + m_ * __builtin_bit_cast(float, w_.z & 0xffff0000u); hi_[2] = o_ + m_ * __builtin_bit_cast(float, w_.w << 16); hi_[3] = o_ + m_ * __builtin_bit_cast(float, w_.w & 0xffff0000u); \
            *(f32x4*)d_ = lo_; *(f32x4*)(d_ + 4) = hi_; }
#define SC_LSTORE(st) { float* sb_ = (float*)(lds + (st) * SC_STAGE); \
            SC_CVT8(sb_ + ((tid / 128) * SCH + sst) * 64 + sch8, g0, false) \
            SC_CVT8(sb_ + ((2 + tid / 128) * SCH + sst) * 64 + sch8, g1, tid < 128) \
            if (tid < 128) { SC_CVT8(sb_ + (4 * SCH + sst) * 64 + sch8, g2, false) } \
            else if (tid < 160) { SC_CVT8(sb_ + 5 * SCH * 64 + vst * 16 + (tid % 2) * 8, gv, false) } }
        __syncthreads();
        SC_GLOAD(0) SC_LSTORE(0)
        __syncthreads();
        constexpr int NCHK = SQ / SCH;
        float* yp = (float*)(lds + SC_YOFF);
        for (int ch = 0; ch <= NCHK; ++ch) {
            if (ch > 0) { const f32x4* q4 = (const f32x4*)(yp + tid * 16); const f32x4 s4 = (q4[0] + q4[1]) + (q4[2] + q4[3]);
                yout[(size_t)scan_tok(b, dir, (ch - 1) * SCH + (tid >> 4)) * 512] = f2bf((s4[0] + s4[1]) + (s4[2] + s4[3])); }
            if (ch == NCHK) break;
            __syncthreads();
            if (ch + 1 < NCHK) SC_GLOAD(ch + 1)
            const float* sb = (const float*)(lds + (ch & 1) * SC_STAGE);
            ScanIn x[3]; scan_load(x[0], sb, 0, kc, vrow); scan_load(x[1], sb, 1, kc, vrow);
#pragma unroll
            for (int st = 0; st < SCH; ++st) {
                if (st + 2 < SCH) scan_load(x[(st + 2) % 3], sb, st + 2, kc, vrow);
                yp[(st * 16 + vrow) * 16 + kc] = scan_step(S, x[st % 3]);
            }
            if (ch + 1 < NCHK) SC_LSTORE((ch + 1) & 1)
            __syncthreads();
        }
#undef SC_GLOAD
#undef SC_CVT8
#undef SC_LSTORE
    }
}


constexpr int CK_RAW = 0;
constexpr int CK_AT = 24576, CK_RT = CK_AT + 2048, CK_BT = CK_RT + 2048, CK_KT = CK_BT + 2048;
constexpr int CK_BCT = CK_KT + 2048, CK_KCT = CK_BCT + 2048, CK_VT = CK_KCT + 2048;
constexpr int CK_CC = CK_VT + 2048;
constexpr int CK_MBQ = CK_CC + 256;
constexpr int CK_MKT = CK_MBQ + 1024, CK_NKT = CK_MKT + 512, CK_NBT = CK_NKT + 512;
constexpr int CK_G0 = CK_NBT + 512;
constexpr int CK_SA = CK_G0 + 4096;
constexpr int CK_Y = CK_SA + 2048;
constexpr int CK_END = CK_Y + 4096;
static_assert(CK_END <= LDS_BYTES, "chunked scan LDS");
DEVFN bf16x8 ck_frag_perm(const unsigned char* img, int row, int m, int g) {
    const u32x2 lo = *(const u32x2*)(img + row * 128 + (32 * m + 4 * g) * 2), hi = *(const u32x2*)(img + row * 128 + (32 * m + 16 + 4 * g) * 2);
    u32x4 w; w.x = lo.x; w.y = lo.y; w.z = hi.x; w.w = hi.y; return __builtin_bit_cast(bf16x8, w);
}
DEVFN bf16x8 ck_frag16(const unsigned char* img, int row, int g) {
    u32x4 w = (u32x4){0u, 0u, 0u, 0u}; if (g < 2) w = *(const u32x4*)(img + row * 32 + g * 16); return __builtin_bit_cast(bf16x8, w);
}
DEVFN bf16x8 ck_frag16p(const unsigned char* img, int row, int g) {
    const u32x2 lo = *(const u32x2*)(img + row * 32 + g * 8); return __builtin_bit_cast(bf16x8, (u32x4){lo.x, lo.y, 0u, 0u});
}
template <int VARC = 0> DEVNI void bk_rwkv_chunk(const Params& p, unsigned char* lds) {
    const int tid = TIDX, lane = tid & 63, wave = tid >> 6, fr = lane & 15, g = lane >> 4;
    for (int it = blockIdx.x; it < NB * 8 * 2; it += gridDim.x) {
        const int dir = it & 1, h = (it >> 1) & 7, b = it >> 4;
        const bf16_t* arr[6] = {p.fkk(), p.fr(), dir ? p.fomw1() : p.fomw0(), dir ? p.fkka1() : p.fkka0(), dir ? p.fkt1() : p.fkt0(), p.fv()};
        bf16_t* yout = (dir ? p.ybw() : p.yf()) + h * 64;
        f32x4 X[4];
#pragma unroll
        for (int j = 0; j < 4; ++j) X[j] = (f32x4){0.f, 0.f, 0.f, 0.f};
        u32x4 gr[3];
#define CK_GLOAD(ch) { _Pragma("unroll") for (int i = 0; i < 3; ++i) { const int c_ = tid + 256 * i, a_ = c_ >> 7, st_ = (c_ & 127) >> 3, c8_ = c_ & 7; \
            gr[i] = *(const u32x4*)(arr[a_] + (size_t)scan_tok(b, dir, (ch) * 16 + st_) * 512 + h * 64 + c8_ * 8); } }
#define CK_LSTORE(bf) { _Pragma("unroll") for (int i = 0; i < 3; ++i) { const int c_ = tid + 256 * i; *(u32x4*)(lds + CK_RAW + (bf) * 12288 + c_ * 16) = gr[i]; } }
        constexpr int NCHK = SQ / 16;
        __syncthreads();
        CK_GLOAD(0) CK_LSTORE(0)
        for (int ch = 0; ch < NCHK; ++ch) {
            __syncthreads();
            if (ch > 0) { const int t_ = tid >> 4, v4_ = (tid & 15) * 4;
                *(u32x2*)(yout + (size_t)scan_tok(b, dir, (ch - 1) * 16 + t_) * 512 + v4_) = *(const u32x2*)(lds + CK_Y + ((ch - 1) & 1) * 2048 + (t_ * 64 + v4_) * 2); }
            if (ch + 1 < NCHK) CK_GLOAD(ch + 1)
            if (VARC != 2) { const bf16_t* raw = (const bf16_t*)(lds + CK_RAW + (ch & 1) * 12288); const int k = lane;
              float c = 1.f, cprev[4], ccur[4];
#pragma unroll
              for (int t = 0; t < 16; ++t) { const float cp = c; c *= 1.0f - bf2f(raw[(2 * 16 + t) * 64 + k]); if ((t >> 2) == wave) { cprev[t & 3] = cp; ccur[t & 3] = c; } }
              const float c16 = c; float bcv[4], kcv[4], vv[4];
#pragma unroll
              for (int q = 0; q < 4; ++q) { const int t = 4 * wave + q; const float rc = FAST_RCP(ccur[q]);
                  const float al = bf2f(raw[(0 * 16 + t) * 64 + k]), rr = bf2f(raw[(1 * 16 + t) * 64 + k]), be = bf2f(raw[(3 * 16 + t) * 64 + k]), ka = bf2f(raw[(4 * 16 + t) * 64 + k]);
                  *(bf16_t*)(lds + CK_AT + (t * 64 + k) * 2) = f2bf(al * cprev[q]); *(bf16_t*)(lds + CK_RT + (t * 64 + k) * 2) = f2bf(rr * ccur[q]);
                  const float bt = be * rc, kt = ka * rc; *(bf16_t*)(lds + CK_BT + (t * 64 + k) * 2) = f2bf(bt); *(bf16_t*)(lds + CK_KT + (t * 64 + k) * 2) = f2bf(kt);
                  bcv[q] = bt * c16; kcv[q] = kt * c16; vv[q] = bf2f(raw[(5 * 16 + t) * 64 + k]); }
              { u32x2 w; w.x = pack2bf(bcv[0], bcv[1]); w.y = pack2bf(bcv[2], bcv[3]); *(u32x2*)(lds + CK_BCT + k * 32 + wave * 8) = w; }
              { u32x2 w; w.x = pack2bf(kcv[0], kcv[1]); w.y = pack2bf(kcv[2], kcv[3]); *(u32x2*)(lds + CK_KCT + k * 32 + wave * 8) = w; }
              { u32x2 w; w.x = pack2bf(vv[0], vv[1]); w.y = pack2bf(vv[2], vv[3]); *(u32x2*)(lds + CK_VT + k * 32 + wave * 8) = w; }
              if (wave == 0) *(float*)(lds + CK_CC + k * 4) = c16; }
            __syncthreads();
            if (VARC != 2) { const unsigned char* ai = lds + ((wave == 0 || wave == 1) ? CK_AT : CK_RT); const unsigned char* bi = lds + ((wave == 0 || wave == 2) ? CK_BT : CK_KT);
              f32x4 d = (f32x4){0.f, 0.f, 0.f, 0.f};
#pragma unroll
              for (int ks = 0; ks < 2; ++ks) d = MFMA16(*(const bf16x8*)(ai + fr * 128 + (32 * ks + 8 * g) * 2), *(const bf16x8*)(bi + fr * 128 + (32 * ks + 8 * g) * 2), d);
              const int i = fr;
#pragma unroll
              for (int r = 0; r < 4; ++r) { const int t = 4 * g + r; const bool keep = (wave < 2) ? (i < t) : (i <= t); const float val = keep ? d[r] : 0.f;
                  if (wave == 0) *(float*)(lds + CK_MBQ + ((t * 4 + (i & 3)) * 4 + (i >> 2)) * 4) = val;
                  else *(bf16_t*)(lds + (wave == 1 ? CK_MKT : wave == 2 ? CK_NBT : CK_NKT) + (t * 16 + i) * 2) = f2bf(val); } }
            __syncthreads();
            if (VARC == 3) { if (ch + 1 < NCHK) CK_LSTORE((ch + 1) & 1) continue; }
            bf16x8 sb[2];
#pragma unroll
            for (int m = 0; m < 2; ++m) { u32x4 w; w.x = pack2bf(X[2 * m][0], X[2 * m][1]); w.y = pack2bf(X[2 * m][2], X[2 * m][3]); w.z = pack2bf(X[2 * m + 1][0], X[2 * m + 1][1]); w.w = pack2bf(X[2 * m + 1][2], X[2 * m + 1][3]); sb[m] = __builtin_bit_cast(bf16x8, w); }
            const bf16x8 vb = ck_frag16(lds + CK_VT, 16 * wave + fr, g);
            { f32x4 d = (f32x4){0.f, 0.f, 0.f, 0.f};
#pragma unroll
              for (int m = 0; m < 2; ++m) d = MFMA16(ck_frag_perm(lds + CK_AT, fr, m, g), sb[m], d);
              d = MFMA16(ck_frag16(lds + CK_MKT, fr, g), vb, d);
              *(f32x4*)(lds + CK_G0 + ((16 * wave + fr) * 16 + 4 * g) * 4) = d; }
            WAVE_SYNC()
            { const int q = lane & 3, v = 16 * wave + (lane >> 2); float sq[4] = {0.f, 0.f, 0.f, 0.f};
#pragma unroll
              for (int t = 0; t < (VARC == 1 ? 1 : 16); ++t) { const f32x4 mb = *(const f32x4*)(lds + CK_MBQ + (t * 4 + q) * 16);
                  float part = (sq[0] * mb[0] + sq[1] * mb[1]) + (sq[2] * mb[2] + sq[3] * mb[3]);
                  part += QUAD_XOR1(part); part += QUAD_XOR2(part);
                  const float val = *(const float*)(lds + CK_G0 + (v * 16 + t) * 4) - part;
                  if (q == (t & 3)) sq[t >> 2] = val; }
#pragma unroll
              for (int m = 0; m < 4; ++m) *(bf16_t*)(lds + CK_SA + (v * 16 + 4 * m + q) * 2) = f2bf(-sq[m]); }
            WAVE_SYNC()
            { const bf16x8 nsa = ck_frag16(lds + CK_SA, 16 * wave + fr, g);
              f32x4 y = (f32x4){0.f, 0.f, 0.f, 0.f};
#pragma unroll
              for (int m = 0; m < 2; ++m) y = MFMA16(ck_frag_perm(lds + CK_RT, fr, m, g), sb[m], y);
              y = MFMA16(ck_frag16(lds + CK_NKT, fr, g), vb, y);
              y = MFMA16(ck_frag16(lds + CK_NBT, fr, g), nsa, y);
#pragma unroll
              for (int r = 0; r < 4; ++r) *(bf16_t*)(lds + CK_Y + (ch & 1) * 2048 + ((4 * g + r) * 64 + 16 * wave + fr) * 2) = f2bf(y[r]);
#pragma unroll
              for (int j = 0; j < 4; ++j) { const f32x4 cc = *(const f32x4*)(lds + CK_CC + (16 * j + 4 * g) * 4); f32x4 d = X[j] * cc;
                  d = MFMA16(ck_frag16(lds + CK_BCT, 16 * j + fr, g), nsa, d);
                  d = MFMA16(ck_frag16(lds + CK_KCT, 16 * j + fr, g), vb, d); X[j] = d; } }
            if (ch + 1 < NCHK) CK_LSTORE((ch + 1) & 1)
        }
        __syncthreads();
        { const int t_ = tid >> 4, v4_ = (tid & 15) * 4;
          *(u32x2*)(yout + (size_t)scan_tok(b, dir, (NCHK - 1) * 16 + t_) * 512 + v4_) = *(const u32x2*)(lds + CK_Y + ((NCHK - 1) & 1) * 2048 + (t_ * 64 + v4_) * 2); }
#undef CK_GLOAD
#undef CK_LSTORE
    }
}


constexpr int C2_RAW = 0;
constexpr int C2_IMG = 24576, C2_IMGSZ = 6 * 2048 + 512 + 256;
constexpr int C2_AT = 0, C2_RT = 2048, C2_BT = 4096, C2_KT = 6144, C2_BCT = 8192, C2_KCT = 10240, C2_VT = 12288, C2_CC = 12800;
constexpr int C2_GRAM = C2_IMG + 2 * C2_IMGSZ, C2_GRAMSZ = 2560;
constexpr int C2_MBQ = 0, C2_MKT = 1024, C2_NKT = 1536, C2_NBT = 2048;
constexpr int C2_G0 = C2_GRAM + 2 * C2_GRAMSZ, C2_SA = C2_G0 + 1024, C2_Y = C2_SA + 512, C2_CNT = C2_Y + 2 * 512, C2_END = C2_CNT + 16;
static_assert(C2_END <= LDS_BYTES, "chunked scan LDS");
template <int VARP = 0> DEVNI void bk_rwkv_chunk2(const Params& p, unsigned char* lds) {
    const int tid = TIDX, lane = tid & 63, wave = tid >> 6, fr = lane & 15, g = lane >> 4;
    constexpr int NCHK = SQ / 16;
    for (int it0 = blockIdx.x; it0 < NB * 8 * 2 * 4; it0 += gridDim.x) {
        const int it = (gridDim.x % 32 == 0) ? (((it0 & 7) + 8 * (it0 >> 5)) * 4 + ((it0 >> 3) & 3)) : it0;
        const int vt = it & 3, dir = (it >> 2) & 1, h = (it >> 3) & 7, b = it >> 6;
        const bf16_t* arr[6] = {p.fkk(), p.fr(), dir ? p.fomw1() : p.fomw0(), dir ? p.fkka1() : p.fkka0(), dir ? p.fkt1() : p.fkt0(), p.fv()};
        bf16_t* yout = (dir ? p.ybw() : p.yf()) + h * 64 + vt * 16;
        f32x4 X[4];
#pragma unroll
        for (int j = 0; j < 4; ++j) X[j] = (f32x4){0.f, 0.f, 0.f, 0.f};
        u32x4 grA[3], grB[3];
#define C2_GLOAD(ch, gr) { _Pragma("unroll") for (int i = 0; i < 3; ++i) { const int c_ = tid + 256 * i, a_ = c_ >> 7, st_ = (c_ & 127) >> 3, c8_ = c_ & 7; \
            gr[i] = *(const u32x4*)(arr[a_] + (size_t)scan_tok(b, dir, (ch) * 16 + st_) * 512 + h * 64 + c8_ * 8); } }
#define C2_LSTORE(bf, gr) { _Pragma("unroll") for (int i = 0; i < 3; ++i) { const int c_ = tid + 256 * i; *(u32x4*)(lds + C2_RAW + (bf) * 12288 + c_ * 16) = gr[i]; } }
#define C2_PREP(ch, ib) if (wave > 0) { const bf16_t* raw = (const bf16_t*)(lds + C2_RAW + ((ch) & 1) * 12288); unsigned char* im = lds + C2_IMG + (ib) * C2_IMGSZ; const int k = lane; \
            float wv[16], xa[16], xb[16]; \
            _Pragma("unroll") for (int t = 0; t < 16; ++t) { wv[t] = 1.0f - bf2f(raw[(2 * 16 + t) * 64 + k]); xa[t] = bf2f(raw[((wave == 1 ? 0 : wave == 2 ? 3 : 4) * 16 + t) * 64 + k]); xb[t] = (wave == 1) ? bf2f(raw[(1 * 16 + t) * 64 + k]) : 0.f; } \
            float c = 1.f, cc[17]; cc[0] = 1.f; \
            _Pragma("unroll") for (int t = 0; t < 16; ++t) { c *= wv[t]; cc[t + 1] = c; } \
            if (wave == 1) { _Pragma("unroll") for (int t = 0; t < 16; ++t) { *(bf16_t*)(im + C2_AT + (t * 64 + k) * 2) = f2bf(xa[t] * cc[t]); *(bf16_t*)(im + C2_RT + (t * 64 + k) * 2) = f2bf(xb[t] * cc[t + 1]); } \
                *(float*)(im + C2_CC + k * 4) = c; } \
            else { float sc[16]; \
                _Pragma("unroll") for (int t = 0; t < 16; ++t) { const float xt = xa[t] * FAST_RCP(cc[t + 1]); *(bf16_t*)(im + (wave == 2 ? C2_BT : C2_KT) + (t * 64 + k) * 2) = f2bf(xt); sc[t] = xt * c; } \
                u32x4 w0, w1; w0.x = pack2bf(sc[0], sc[1]); w0.y = pack2bf(sc[2], sc[3]); w0.z = pack2bf(sc[4], sc[5]); w0.w = pack2bf(sc[6], sc[7]); \
                w1.x = pack2bf(sc[8], sc[9]); w1.y = pack2bf(sc[10], sc[11]); w1.z = pack2bf(sc[12], sc[13]); w1.w = pack2bf(sc[14], sc[15]); \
                *(u32x4*)(im + (wave == 2 ? C2_BCT : C2_KCT) + k * 32) = w0; *(u32x4*)(im + (wave == 2 ? C2_BCT : C2_KCT) + k * 32 + 16) = w1; \
                if (wave == 3 && lane < 16) { bf16_t vv[16]; _Pragma("unroll") for (int t = 0; t < 16; ++t) vv[t] = raw[(5 * 16 + t) * 64 + vt * 16 + lane]; \
                    u32x4 v0, v1; v0.x = vv[0] | ((unsigned)vv[1] << 16); v0.y = vv[2] | ((unsigned)vv[3] << 16); v0.z = vv[4] | ((unsigned)vv[5] << 16); v0.w = vv[6] | ((unsigned)vv[7] << 16); \
                    v1.x = vv[8] | ((unsigned)vv[9] << 16); v1.y = vv[10] | ((unsigned)vv[11] << 16); v1.z = vv[12] | ((unsigned)vv[13] << 16); v1.w = vv[14] | ((unsigned)vv[15] << 16); \
                    *(u32x4*)(im + C2_VT + lane * 32) = v0; *(u32x4*)(im + C2_VT + lane * 32 + 16) = v1; } } }
#define C2_GRAM1(ib, AI, BI, KIND) { const unsigned char* im = lds + C2_IMG + (ib) * C2_IMGSZ; unsigned char* gm = lds + C2_GRAM + (ib) * C2_GRAMSZ; f32x4 d = (f32x4){0.f, 0.f, 0.f, 0.f}; \
            _Pragma("unroll") for (int ks = 0; ks < 2; ++ks) d = MFMA16(*(const bf16x8*)(im + (AI) + fr * 128 + (32 * ks + 8 * g) * 2), *(const bf16x8*)(im + (BI) + fr * 128 + (32 * ks + 8 * g) * 2), d); \
            _Pragma("unroll") for (int r = 0; r < 4; ++r) { const int t = 4 * g + r, i = fr; const bool keep = ((KIND) < 2) ? (i < t) : (i <= t); const float val = keep ? d[r] : 0.f; \
                if ((KIND) == 0) *(float*)(gm + C2_MBQ + ((t * 4 + (i & 3)) * 4 + (i >> 2)) * 4) = val; \
                else *(bf16_t*)(gm + ((KIND) == 1 ? C2_MKT : (KIND) == 2 ? C2_NBT : C2_NKT) + (t * 16 + i) * 2) = f2bf(val); } }
#define C2_GRAMS(ib) { if (wave == 1) C2_GRAM1(ib, C2_AT, C2_BT, 0) else if (wave == 2) { C2_GRAM1(ib, C2_AT, C2_KT, 1) C2_GRAM1(ib, C2_RT, C2_BT, 2) } else if (wave == 3) C2_GRAM1(ib, C2_RT, C2_KT, 3) }
        auto c2_body = [&](const int ch, const int ib) {
            if (wave == 0 && (VARP == 3 || VARP == 4)) { }
            else if (wave == 0) {
                const unsigned char* im = lds + C2_IMG + ib * C2_IMGSZ; const unsigned char* gm = lds + C2_GRAM + ib * C2_GRAMSZ;
                if (ch > 0 && lane < 32) { const int t_ = lane >> 1, hf = lane & 1;
                    *(u32x4*)(yout + (size_t)scan_tok(b, dir, (ch - 1) * 16 + t_) * 512 + hf * 8) = *(const u32x4*)(lds + C2_Y + ((ch - 1) & 1) * 512 + t_ * 32 + hf * 16); }
                bf16x8 sb[2];
#pragma unroll
                for (int m = 0; m < 2; ++m) { u32x4 w; w.x = pack2bf(X[2 * m][0], X[2 * m][1]); w.y = pack2bf(X[2 * m][2], X[2 * m][3]); w.z = pack2bf(X[2 * m + 1][0], X[2 * m + 1][1]); w.w = pack2bf(X[2 * m + 1][2], X[2 * m + 1][3]); sb[m] = __builtin_bit_cast(bf16x8, w); }
                const bf16x8 vb = ck_frag16(im + C2_VT, fr, g);
                const bf16x8 a0 = ck_frag_perm(im + C2_AT, fr, 0, g), a1 = ck_frag_perm(im + C2_AT, fr, 1, g), r0 = ck_frag_perm(im + C2_RT, fr, 0, g), r1 = ck_frag_perm(im + C2_RT, fr, 1, g);
                const bf16x8 mk = ck_frag16(gm + C2_MKT, fr, g), nk = ck_frag16(gm + C2_NKT, fr, g), nb = ck_frag16(gm + C2_NBT, fr, g);
                bf16x8 kcf[4], bcf[4]; f32x4 ccv[4];
#pragma unroll
                for (int j = 0; j < 4; ++j) { kcf[j] = ck_frag16(im + C2_KCT, 16 * j + fr, g); bcf[j] = ck_frag16(im + C2_BCT, 16 * j + fr, g); ccv[j] = *(const f32x4*)(im + C2_CC + (16 * j + 4 * g) * 4); }
                const int q = lane & 3, vv = lane >> 2; f32x4 mbv[16];
#pragma unroll
                for (int t = 0; t < 16; ++t) mbv[t] = *(const f32x4*)(gm + C2_MBQ + (t * 4 + q) * 16);
                f32x4 d = (f32x4){0.f, 0.f, 0.f, 0.f}; d = MFMA16(a0, sb[0], d); d = MFMA16(a1, sb[1], d); d = MFMA16(mk, vb, d);
                f32x4 y = (f32x4){0.f, 0.f, 0.f, 0.f}; y = MFMA16(r0, sb[0], y); y = MFMA16(r1, sb[1], y); y = MFMA16(nk, vb, y);
#pragma unroll
                for (int j = 0; j < 4; ++j) X[j] = MFMA16(kcf[j], vb, X[j] * ccv[j]);
                *(f32x4*)(lds + C2_G0 + (fr * 16 + 4 * g) * 4) = d;
                WAVE_SYNC()
                f32x4 g0v[4];
#pragma unroll
                for (int m = 0; m < 4; ++m) g0v[m] = *(const f32x4*)(lds + C2_G0 + (vv * 16 + 4 * m) * 4);
                float sq[4] = {0.f, 0.f, 0.f, 0.f};
#pragma unroll
                for (int t = 0; t < (VARP == 2 ? 1 : 16); ++t) { float part = (sq[0] * mbv[t][0] + sq[1] * mbv[t][1]) + (sq[2] * mbv[t][2] + sq[3] * mbv[t][3]);
                    part += QUAD_XOR1(part); part += QUAD_XOR2(part);
                    const float val = g0v[t >> 2][t & 3] - part; if (q == (t & 3)) sq[t >> 2] = val; }
#pragma unroll
                for (int m = 0; m < 4; ++m) *(bf16_t*)(lds + C2_SA + (vv * 16 + 4 * m + q) * 2) = f2bf(-sq[m]);
                WAVE_SYNC()
                const bf16x8 nsa = ck_frag16(lds + C2_SA, fr, g);
                y = MFMA16(nb, nsa, y);
#pragma unroll
                for (int j = 0; j < 4; ++j) X[j] = MFMA16(bcf[j], nsa, X[j]);
#pragma unroll
                for (int r = 0; r < 4; ++r) *(bf16_t*)(lds + C2_Y + ib * 512 + ((4 * g + r) * 16 + fr) * 2) = f2bf(y[r]);
            } else {
                if (ch + 1 < NCHK && VARP != 1 && VARP != 4) C2_PREP(ch + 1, ib ^ 1)
                {
                  volatile int* cnt = (volatile int*)(lds + C2_CNT); WAVE_SYNC()
                  if (lane == 0) atomicAdd((int*)(lds + C2_CNT), 1);
                  const int want = 3 * (ch + 2); while (*cnt < want) SPIN_PAUSE();
                  WAVE_SYNC() }
                if (ch + 1 < NCHK && VARP != 1 && VARP != 4) C2_GRAMS(ib ^ 1)
            }
        };
#define C2_BODY(ch, ib) c2_body(ch, ib);
        static_assert(NCHK % 2 == 0 && NCHK >= 4, "chunk pairs");
        __syncthreads();
        C2_GLOAD(0, grA) C2_LSTORE(0, grA)
        C2_GLOAD(1, grB) C2_GLOAD(2, grA)
        if (tid == 0) *(int*)(lds + C2_CNT) = 3;
        __syncthreads();
        C2_PREP(0, 0)
        C2_LSTORE(1, grB)
        __syncthreads();
        C2_GRAMS(0)
        __syncthreads();
#define C2_ITER(ch, GR_LOAD, GR_STORE) { \
            const int ib = (ch) & 1; \
            if ((ch) + 3 < NCHK) C2_GLOAD((ch) + 3, GR_LOAD) \
            C2_BODY(ch, ib) \
            if ((ch) + 2 < NCHK) C2_LSTORE((ch) & 1, GR_STORE) \
            __syncthreads(); }
        for (int ch = 0; ch < NCHK; ch += 2) {
            C2_ITER(ch, grB, grA)
            C2_ITER(ch + 1, grA, grB)
        }
#undef C2_ITER
        if (wave == 0 && lane < 32) { const int t_ = lane >> 1, hf = lane & 1;
            *(u32x4*)(yout + (size_t)scan_tok(b, dir, (NCHK - 1) * 16 + t_) * 512 + hf * 8) = *(const u32x4*)(lds + C2_Y + ((NCHK - 1) & 1) * 512 + t_ * 32 + hf * 16); }
#undef C2_GLOAD
#undef C2_LSTORE
#undef C2_PREP
#undef C2_GRAM1
#undef C2_GRAMS
#undef C2_BODY
    }
}

constexpr int C3_RAW = 0;
constexpr int C3_IMG = 24576, C3_IMGSZ = 6 * 2048 + 1024 + 256;
constexpr int C3_AT = 0, C3_RT = 2048, C3_BT = 4096, C3_KT = 6144, C3_BCT = 8192, C3_KCT = 10240, C3_VT = 12288, C3_CC = 13312;
constexpr int C3_GRAM = C3_IMG + 2 * C3_IMGSZ, C3_GRAMSZ = 2560;
constexpr int C3_MBQ = 0, C3_MKT = 1024, C3_NKT = 1536, C3_NBT = 2048;
constexpr int C3_G0 = C3_GRAM + 2 * C3_GRAMSZ, C3_SA = C3_G0 + 2048, C3_Y = C3_SA + 1024, C3_CNT = C3_Y + 2 * 1024, C3_END = C3_CNT + 16;
static_assert(C3_END <= LDS_BYTES, "chunked scan LDS");
DEVNI void bk_rwkv_chunk3(const Params& p, unsigned char* lds) {
    const int tid = TIDX, lane = tid & 63, wave = tid >> 6, fr = lane & 15, g = lane >> 4;
    constexpr int NCHK = SQ / 16;
    if (wave == 0) { SETPRIO(3); }
    for (int it0 = blockIdx.x; it0 < NB * 8 * 2 * 2; it0 += gridDim.x) {
        const int it = (gridDim.x % 16 == 0) ? (((it0 & 7) + 8 * (it0 >> 4)) * 2 + ((it0 >> 3) & 1)) : it0;
        const int half = it & 1, dir = (it >> 1) & 1, h = (it >> 2) & 7, b = it >> 5; const int vt = half;
        const bf16_t* arr[6] = {p.fkk(), p.fr(), dir ? p.fomw1() : p.fomw0(), dir ? p.fkka1() : p.fkka0(), dir ? p.fkt1() : p.fkt0(), p.fv()};
        bf16_t* yout = (dir ? p.ybw() : p.yf()) + h * 64 + half * 32;
        f32x4 X[2][4];
#pragma unroll
        for (int u = 0; u < 2; ++u)
#pragma unroll
            for (int j = 0; j < 4; ++j) X[u][j] = (f32x4){0.f, 0.f, 0.f, 0.f};
        u32x4 grA[4], grB[4];
#define C3_GLOAD(ch, gr) if (wave > 0) { _Pragma("unroll") for (int i = 0; i < 4; ++i) { const int c_ = (tid - 64) + 192 * i, a_ = c_ >> 7, st_ = (c_ & 127) >> 3, c8_ = c_ & 7; \
            gr[i] = *(const u32x4*)(arr[a_] + (size_t)scan_tok(b, dir, (ch) * 16 + st_) * 512 + h * 64 + c8_ * 8); } }
#define C3_LSTORE(bf, gr) if (wave > 0) { _Pragma("unroll") for (int i = 0; i < 4; ++i) { const int c_ = (tid - 64) + 192 * i; *(u32x4*)(lds + C3_RAW + (bf) * 12288 + c_ * 16) = gr[i]; } }
#define C3_PREP(ch, ib) if (wave > 0) { const bf16_t* raw = (const bf16_t*)(lds + C3_RAW + ((ch) & 1) * 12288); unsigned char* im = lds + C3_IMG + (ib) * C3_IMGSZ; const int k = lane; \
            const int pk = (k & 32) + 8 * ((k & 15) >> 2) + 4 * ((k >> 4) & 1) + (k & 3);        \
            float wv[16], xa[16], xb[16]; \
            _Pragma("unroll") for (int t = 0; t < 16; ++t) { wv[t] = 1.0f - bf2f(raw[(2 * 16 + t) * 64 + k]); xa[t] = bf2f(raw[((wave == 1 ? 0 : wave == 2 ? 3 : 4) * 16 + t) * 64 + k]); xb[t] = (wave == 1) ? bf2f(raw[(1 * 16 + t) * 64 + k]) : 0.f; } \
            float c = 1.f, cc[17]; cc[0] = 1.f; \
            _Pragma("unroll") for (int t = 0; t < 16; ++t) { c *= wv[t]; cc[t + 1] = c; } \
            if (wave == 1) { _Pragma("unroll") for (int t = 0; t < 16; ++t) { *(bf16_t*)(im + C3_AT + (t * 64 + pk) * 2) = f2bf(xa[t] * cc[t]); *(bf16_t*)(im + C3_RT + (t * 64 + pk) * 2) = f2bf(xb[t] * cc[t + 1]); } \
                *(float*)(im + C3_CC + k * 4) = c; } \
            else { float sc[16]; float suf = 1.0f; const float rc16 = FAST_RCP(c);            \
                _Pragma("unroll") for (int t = 15; t >= 0; --t) { sc[t] = xa[t] * suf; *(bf16_t*)(im + (wave == 2 ? C3_BT : C3_KT) + (t * 64 + pk) * 2) = f2bf(sc[t] * rc16); suf *= wv[t]; } \
                u32x4 w0, w1; w0.x = pack2bf(sc[0], sc[1]); w0.y = pack2bf(sc[2], sc[3]); w0.z = pack2bf(sc[4], sc[5]); w0.w = pack2bf(sc[6], sc[7]); \
                w1.x = pack2bf(sc[8], sc[9]); w1.y = pack2bf(sc[10], sc[11]); w1.z = pack2bf(sc[12], sc[13]); w1.w = pack2bf(sc[14], sc[15]); \
                *(u32x4*)(im + (wave == 2 ? C3_BCT : C3_KCT) + k * 32) = w0; *(u32x4*)(im + (wave == 2 ? C3_BCT : C3_KCT) + k * 32 + 16) = w1; \
                if (wave == 3 && lane < 32) { bf16_t vv[16]; _Pragma("unroll") for (int t = 0; t < 16; ++t) vv[t] = raw[(5 * 16 + t) * 64 + vt * 32 + lane]; \
                    u32x4 v0, v1; v0.x = vv[0] | ((unsigned)vv[1] << 16); v0.y = vv[2] | ((unsigned)vv[3] << 16); v0.z = vv[4] | ((unsigned)vv[5] << 16); v0.w = vv[6] | ((unsigned)vv[7] << 16); \
                    v1.x = vv[8] | ((unsigned)vv[9] << 16); v1.y = vv[10] | ((unsigned)vv[11] << 16); v1.z = vv[12] | ((unsigned)vv[13] << 16); v1.w = vv[14] | ((unsigned)vv[15] << 16); \
                    *(u32x4*)(im + C3_VT + lane * 32) = v0; *(u32x4*)(im + C3_VT + lane * 32 + 16) = v1; } } }
#define C3_GRAM1(ib, AI, BI, KIND) { const unsigned char* im = lds + C3_IMG + (ib) * C3_IMGSZ; unsigned char* gm = lds + C3_GRAM + (ib) * C3_GRAMSZ; f32x4 d = (f32x4){0.f, 0.f, 0.f, 0.f}; \
            _Pragma("unroll") for (int ks = 0; ks < 2; ++ks) d = MFMA16(*(const bf16x8*)(im + (AI) + fr * 128 + (32 * ks + 8 * g) * 2), *(const bf16x8*)(im + (BI) + fr * 128 + (32 * ks + 8 * g) * 2), d); \
            _Pragma("unroll") for (int r = 0; r < 4; ++r) { const int t = 4 * g + r, i = fr; const bool keep = ((KIND) < 2) ? (i < t) : (i <= t); const float val = keep ? d[r] : 0.f; \
                if ((KIND) == 0) *(float*)(gm + C3_MBQ + ((i * 4 + (t & 3)) * 4 + (t >> 2)) * 4) = val;        \
                else *(bf16_t*)(gm + ((KIND) == 1 ? C3_MKT : (KIND) == 2 ? C3_NBT : C3_NKT) + (t * 16 + i) * 2) = f2bf(val); } }
#define C3_GRAMS_ALL(ib) { const unsigned char* im_ = lds + C3_IMG + (ib) * C3_IMGSZ; unsigned char* gm_ = lds + C3_GRAM + (ib) * C3_GRAMSZ; \
            f32x4 dMb = (f32x4){0.f, 0.f, 0.f, 0.f}, dMk = dMb, dNb = dMb, dNk = dMb; \
            _Pragma("unroll") for (int ks = 0; ks < 2; ++ks) { const int o_ = fr * 128 + (32 * ks + 8 * g) * 2; \
                const bf16x8 fa_ = *(const bf16x8*)(im_ + C3_AT + o_), fr_ = *(const bf16x8*)(im_ + C3_RT + o_), fb_ = *(const bf16x8*)(im_ + C3_BT + o_), fk_ = *(const bf16x8*)(im_ + C3_KT + o_); \
                dMb = MFMA16(fa_, fb_, dMb); dMk = MFMA16(fa_, fk_, dMk); dNb = MFMA16(fr_, fb_, dNb); dNk = MFMA16(fr_, fk_, dNk); } \
            _Pragma("unroll") for (int r = 0; r < 4; ++r) { const int t = 4 * g + r, i = fr; \
                *(float*)(gm_ + C3_MBQ + ((i * 4 + (t & 3)) * 4 + (t >> 2)) * 4) = (i < t) ? dMb[r] : 0.f;        \
                *(bf16_t*)(gm_ + C3_MKT + (t * 16 + i) * 2) = f2bf((i < t) ? dMk[r] : 0.f); \
                *(bf16_t*)(gm_ + C3_NBT + (t * 16 + i) * 2) = f2bf((i <= t) ? dNb[r] : 0.f); \
                *(bf16_t*)(gm_ + C3_NKT + (t * 16 + i) * 2) = f2bf((i <= t) ? dNk[r] : 0.f); } }
        auto c2_body = [&](const int ch, const int ib) {
            if (wave == 0 && (0 == 3 || 0 == 4)) { }
            else if (wave == 0) {
                const unsigned char* im = lds + C3_IMG + ib * C3_IMGSZ; const unsigned char* gm = lds + C3_GRAM + ib * C3_GRAMSZ;
                if (ch > 0) { const int t_ = lane >> 2, qd = lane & 3;
                    *(u32x4*)(yout + (size_t)scan_tok(b, dir, (ch - 1) * 16 + t_) * 512 + qd * 8) = *(const u32x4*)(lds + C3_Y + ((ch - 1) & 1) * 1024 + t_ * 64 + qd * 16); }
                bf16x8 mk, nk, nb, afr[2], rfr[2];
                { f32x4 dMb = (f32x4){0.f, 0.f, 0.f, 0.f}, dMkT = dMb, dNkT = dMb, dNbT = dMb;
#pragma unroll
                  for (int ks = 0; ks < 2; ++ks) { const int o_ = fr * 128 + (32 * ks + 8 * g) * 2;
                      const bf16x8 fa_ = *(const bf16x8*)(im + C3_AT + o_), fr_ = *(const bf16x8*)(im + C3_RT + o_), fb_ = *(const bf16x8*)(im + C3_BT + o_), fk_ = *(const bf16x8*)(im + C3_KT + o_);
                      afr[ks] = fa_; rfr[ks] = fr_;
                      dMb = MFMA16(fa_, fb_, dMb); dMkT = MFMA16(fk_, fa_, dMkT); dNkT = MFMA16(fk_, fr_, dNkT); dNbT = MFMA16(fb_, fr_, dNbT); }
                  float mkv[4], nkv[4], nbv[4];
#pragma unroll
                  for (int r = 0; r < 4; ++r) { const int t = 4 * g + r, i = fr;
                      *(float*)(lds + C3_GRAM + ib * C3_GRAMSZ + C3_MBQ + ((i * 4 + (t & 3)) * 4 + (t >> 2)) * 4) = (i < t) ? dMb[r] : 0.f;
                      mkv[r] = (t < fr) ? dMkT[r] : 0.f; nkv[r] = (t <= fr) ? dNkT[r] : 0.f; nbv[r] = (t <= fr) ? dNbT[r] : 0.f; }
                  mk = __builtin_bit_cast(bf16x8, (u32x4){pack2bf(mkv[0], mkv[1]), pack2bf(mkv[2], mkv[3]), 0u, 0u});
                  nk = __builtin_bit_cast(bf16x8, (u32x4){pack2bf(nkv[0], nkv[1]), pack2bf(nkv[2], nkv[3]), 0u, 0u});
                  nb = __builtin_bit_cast(bf16x8, (u32x4){pack2bf(nbv[0], nbv[1]), pack2bf(nbv[2], nbv[3]), 0u, 0u}); }
                bf16x8 sb[2][2], vbp[2];
#pragma unroll
                for (int u = 0; u < 2; ++u) {
#pragma unroll
                    for (int m = 0; m < 2; ++m) { u32x4 w; w.x = pack2bf(X[u][2 * m][0], X[u][2 * m][1]); w.y = pack2bf(X[u][2 * m][2], X[u][2 * m][3]); w.z = pack2bf(X[u][2 * m + 1][0], X[u][2 * m + 1][1]); w.w = pack2bf(X[u][2 * m + 1][2], X[u][2 * m + 1][3]); sb[u][m] = __builtin_bit_cast(bf16x8, w); }
                    { const u32x2 lo = *(const u32x2*)(im + C3_VT + (16 * u + fr) * 32 + g * 8); vbp[u] = __builtin_bit_cast(bf16x8, (u32x4){lo.x, lo.y, 0u, 0u}); } }
                const bf16x8 a0 = afr[0], a1 = afr[1], r0 = rfr[0], r1 = rfr[1];
                bf16x8 kcf[4]; f32x4 ccv[4];
#pragma unroll
                for (int j = 0; j < 4; ++j) { kcf[j] = ck_frag16p(im + C3_KCT, 16 * j + fr, g); ccv[j] = *(const f32x4*)(im + C3_CC + (16 * j + 4 * g) * 4); }
                const int q = lane & 3, vv = lane >> 2;
                f32x4 y[2];
#pragma unroll
                for (int u = 0; u < 2; ++u) {
                    f32x4 d = (f32x4){0.f, 0.f, 0.f, 0.f}; d = MFMA16(a0, sb[u][0], d); d = MFMA16(a1, sb[u][1], d); d = MFMA16(mk, vbp[u], d);
                    y[u] = (f32x4){0.f, 0.f, 0.f, 0.f}; y[u] = MFMA16(r0, sb[u][0], y[u]); y[u] = MFMA16(r1, sb[u][1], y[u]); y[u] = MFMA16(nk, vbp[u], y[u]);
#pragma unroll
                    for (int j = 0; j < 4; ++j) X[u][j] = MFMA16(kcf[j], vbp[u], X[u][j] * ccv[j]);
                    *(f32x4*)(lds + C3_G0 + ((16 * u + fr) * 16 + 4 * g) * 4) = d; }
                WAVE_SYNC()
                f32x4 mcv[16];
#pragma unroll
                for (int t = 0; t < 16; ++t) mcv[t] = *(const f32x4*)(gm + C3_MBQ + (t * 4 + q) * 16);
                float sq[2][4];
#pragma unroll
                for (int u = 0; u < 2; ++u)
#pragma unroll
                    for (int m = 0; m < 4; ++m) sq[u][m] = *(const float*)(lds + C3_G0 + ((16 * u + vv) * 16 + 4 * m + q) * 4);
#pragma unroll
                for (int t = 0; t < 15; ++t) {
                    const float s0 = QUAD_BCAST(sq[0][t >> 2], t & 3), s1 = QUAD_BCAST(sq[1][t >> 2], t & 3);
#pragma unroll
                    for (int m = 0; m < 4; ++m) if (4 * m + 3 > t) { sq[0][m] -= mcv[t][m] * s0; sq[1][m] -= mcv[t][m] * s1; } }
#pragma unroll
                for (int u = 0; u < 2; ++u)
#pragma unroll
                    for (int m = 0; m < 4; ++m) *(bf16_t*)(lds + C3_SA + ((16 * u + vv) * 16 + 4 * m + q) * 2) = f2bf(-sq[u][m]);
                WAVE_SYNC()
                bf16x8 bcf[4];
#pragma unroll
                for (int j = 0; j < 4; ++j) bcf[j] = ck_frag16p(im + C3_BCT, 16 * j + fr, g);
#pragma unroll
                for (int u = 0; u < 2; ++u) { const bf16x8 nsa = ck_frag16p(lds + C3_SA, 16 * u + fr, g);
                    y[u] = MFMA16(nb, nsa, y[u]);
#pragma unroll
                    for (int j = 0; j < 4; ++j) X[u][j] = MFMA16(bcf[j], nsa, X[u][j]);
#pragma unroll
                    for (int r = 0; r < 4; ++r) *(bf16_t*)(lds + C3_Y + ib * 1024 + ((4 * g + r) * 32 + 16 * u + fr) * 2) = f2bf(y[u][r]); }
            } else {
                if (ch + 1 < NCHK) C3_PREP(ch + 1, ib ^ 1)
            }
        };
#define C3_BODY(ch, ib) c2_body(ch, ib);
        static_assert(NCHK % 2 == 0 && NCHK >= 4, "chunk pairs");
        __syncthreads();
        C3_GLOAD(0, grA) C3_LSTORE(0, grA)
        C3_GLOAD(1, grB) C3_GLOAD(2, grA)
        if (tid == 0) *(int*)(lds + C3_CNT) = 3;
        __syncthreads();
        C3_PREP(0, 0)
        C3_LSTORE(1, grB)
        __syncthreads();
#define C3_ITER(ch, GR_LOAD, GR_STORE) { \
            const int ib = (ch) & 1; \
            if ((ch) + 3 < NCHK) C3_GLOAD((ch) + 3, GR_LOAD) \
            C3_BODY(ch, ib) \
            if ((ch) + 2 < NCHK) C3_LSTORE((ch) & 1, GR_STORE) \
            __syncthreads(); }
        for (int ch = 0; ch < NCHK; ch += 2) {
            C3_ITER(ch, grB, grA)
            C3_ITER(ch + 1, grA, grB)
        }
#undef C3_ITER
        if (wave == 0) { const int t_ = lane >> 2, qd = lane & 3;
            *(u32x4*)(yout + (size_t)scan_tok(b, dir, (NCHK - 1) * 16 + t_) * 512 + qd * 8) = *(const u32x4*)(lds + C3_Y + ((NCHK - 1) & 1) * 1024 + t_ * 64 + qd * 16); }
#undef C3_GLOAD
#undef C3_LSTORE
#undef C3_PREP
#undef C3_GRAM1
#undef C3_GRAMS_ALL
#undef C3_BODY
    }
    SETPRIO(0);
}


DEVFN void unpack8(const u32x4 w, float* f) {
    f[0] = __builtin_bit_cast(float, w.x << 16); f[1] = __builtin_bit_cast(float, w.x & 0xffff0000u); f[2] = __builtin_bit_cast(float, w.y << 16); f[3] = __builtin_bit_cast(float, w.y & 0xffff0000u);
    f[4] = __builtin_bit_cast(float, w.z << 16); f[5] = __builtin_bit_cast(float, w.z & 0xffff0000u); f[6] = __builtin_bit_cast(float, w.w << 16); f[7] = __builtin_bit_cast(float, w.w & 0xffff0000u);
}
DEVFN u32x4 pack8(const float* f) { u32x4 w; w.x = pack2bf(f[0], f[1]); w.y = pack2bf(f[2], f[3]); w.z = pack2bf(f[4], f[5]); w.w = pack2bf(f[6], f[7]); return w; }

DEVNI void bk_mod(const Params& p, unsigned char* lds) {
    float* sl = (float*)lds;
    const int tid = TIDX, cl = tid & 15, kg = tid >> 4;
    __syncthreads();
    { float cv[NB + 1][4];
#pragma unroll
      for (int r = 0; r <= NB; ++r)
#pragma unroll
          for (int q = 0; q < 4; ++q) cv[r][q] = r < NB ? p.c[r * D + tid + 256 * q] : p.c_ctx[tid + 256 * q];
#pragma unroll
      for (int r = 0; r <= NB; ++r)
#pragma unroll
          for (int q = 0; q < 4; ++q) sl[r * D + tid + 256 * q] = siluf_(cv[r][q]); }
    __syncthreads();
    float* part = sl + (NB + 1) * D;
    for (int it = blockIdx.x; it < 2 * (NMOD / 16); it += gridDim.x) {
        const int l = it / (NMOD / 16), n0 = (it % (NMOD / 16)) * 16;
        const float* wp = p.ada_w + ((size_t)l * D + kg * 64) * NMOD + n0 + cl;
        float wv[64];
#pragma unroll
        for (int k = 0; k < 64; ++k) wv[k] = __builtin_nontemporal_load(wp + (size_t)k * NMOD);
        float acc[NB + 1];
#pragma unroll
        for (int r = 0; r <= NB; ++r) acc[r] = 0.f;
#pragma unroll
        for (int k = 0; k < 64; k += 4)
#pragma unroll
            for (int r = 0; r <= NB; ++r) { const f32x4 sv = *(const f32x4*)(sl + r * D + kg * 64 + k); acc[r] += (sv[0] * wv[k] + sv[1] * wv[k + 1]) + (sv[2] * wv[k + 2] + sv[3] * wv[k + 3]); }
        __syncthreads();
#pragma unroll
        for (int r = 0; r <= NB; ++r) part[(kg * (NB + 1) + r) * 16 + cl] = acc[r];
        __syncthreads();
        if (tid < (NB + 1) * 16) { const int r = tid >> 4, c = tid & 15; float sum = 0.f;
#pragma unroll
            for (int g = 0; g < 16; ++g) sum += part[(g * (NB + 1) + r) * 16 + c];
            p.mod()[((size_t)l * (NB + 1) + r) * NMOD + n0 + c] = p.ada_b[(size_t)l * NMOD + n0 + c] + sum; }
    }
    for (int i = blockIdx.x * 256 + tid; i < 2 * 48 * D; i += gridDim.x * 256) { const int l = i / (48 * D), n = (i / D) % 48, k = i % D;
        const float w = n < 4 ? p.moe_w_grp[((size_t)l * D + k) * 4 + n] : n < 36 ? p.moe_w_exp[((size_t)l * D + k) * 32 + (n - 4)] : 0.f;
        const bf16_t hi = f2bf(w); p.wr_hi()[i] = hi; p.wr_lo()[i] = f2bf(w - bf2f(hi)); }
    for (int i = blockIdx.x * 256 + tid; i < 64; i += gridDim.x * 256) p.mcnt()[i] = 0;
    for (int i = blockIdx.x * 256 + tid; i < 1024; i += gridDim.x * 256) { const float ang = (float)(i / 16) * powf(10000.0f, -(float)(i % 16) / 16.0f); p.ropetab()[2 * i] = cosf(ang); p.ropetab()[2 * i + 1] = sinf(ang); }
}

DEVNI void bk_norm(const Params& p, int layer, int which, int t0, bool dry = false) {
    const int tid = TIDX, lane = tid & 63, wave = tid >> 6, sub = lane >> 4, kq = lane & 15;
    const int ntok = T - t0, ngrp = (ntok + 15) / 16;
    for (int it = blockIdx.x; it < ngrp; it += gridDim.x) {
        const int tk = t0 + it * 16 + wave * 4 + sub;
        const bool fromin = (layer == 0 && which == 1); const float* hf = hin(p, tk); bf16_t* hbr = hrow(p, tk);
        const bool addys = (layer == 1 && which == 1) || which == 3;
        float ss = 0.f; f32x4 xs[16];
#pragma unroll
        for (int j = 0; j < 8; ++j) { const int k = 128 * j + 8 * kq; f32x4 xa, xb;
            if (fromin) { xa = *(const f32x4*)(hf + k); xb = *(const f32x4*)(hf + k + 4); }
            else { float f[8]; unpack8(*(const u32x4*)(hbr + k), f); xa = (f32x4){f[0], f[1], f[2], f[3]}; xb = (f32x4){f[4], f[5], f[6], f[7]}; }
            if (addys) { float a[8], b2[8]; unpack8(*(const u32x4*)(p.ys() + (size_t)(tk * 2) * D + k), a); unpack8(*(const u32x4*)(p.ys() + (size_t)(tk * 2 + 1) * D + k), b2);
                xa += (f32x4){a[0] + b2[0], a[1] + b2[1], a[2] + b2[2], a[3] + b2[3]}; xb += (f32x4){a[4] + b2[4], a[5] + b2[5], a[6] + b2[6], a[7] + b2[7]};
                if (which != 3) { const float o[8] = {xa[0], xa[1], xa[2], xa[3], xb[0], xb[1], xb[2], xb[3]}; *(u32x4*)(hbr + k) = pack8(o); } }
            xs[2 * j] = xa; xs[2 * j + 1] = xb;
            ss += ((xa[0] * xa[0] + xa[1] * xa[1]) + (xa[2] * xa[2] + xa[3] * xa[3])) + ((xb[0] * xb[0] + xb[1] * xb[1]) + (xb[2] * xb[2] + xb[3] * xb[3])); }
        RED16(ss)
        const float rstd = rsqrtf(ss / D + EPS);
        if (which == 3) {
#pragma unroll
            for (int j = 0; j < 8; ++j) { const int k = 128 * j + 8 * kq; xs[2 * j] = xs[2 * j] * *(const f32x4*)(p.final_g + k); xs[2 * j + 1] = xs[2 * j + 1] * *(const f32x4*)(p.final_g + k + 4); }
#pragma unroll
            for (int j = 0; j < 8; ++j) { const int k = 128 * j + 8 * kq; float* o = p.out + (size_t)(tk - TC) * D + k; *(f32x4*)o = xs[2 * j] * rstd; *(f32x4*)(o + 4) = xs[2 * j + 1] * rstd; }
            continue;
        }
        const float* gain = (which == 1 ? p.norm1_g : p.norm2_g) + (size_t)layer * D;
        const int mr = modrow(tk); const float* sh = modp(p, layer, mr, which == 1 ? 0 : 3); const float* sc = modp(p, layer, mr, which == 1 ? 1 : 4);
        if (which == 1) {
#pragma unroll
            for (int hf2 = 0; hf2 < 4; ++hf2) {
#pragma unroll
                for (int j = 2 * hf2; j < 2 * hf2 + 2; ++j) { const int k = 128 * j + 8 * kq;
                    xs[2 * j] = (xs[2 * j] * rstd * *(const f32x4*)(gain + k)) * (*(const f32x4*)(sc + k) + 1.0f) + *(const f32x4*)(sh + k);
                    xs[2 * j + 1] = (xs[2 * j + 1] * rstd * *(const f32x4*)(gain + k + 4)) * (*(const f32x4*)(sc + k + 4) + 1.0f) + *(const f32x4*)(sh + k + 4); }
#pragma unroll
                for (int j = 2 * hf2; j < 2 * hf2 + 2; ++j) { const int k = 128 * j + 8 * kq; const f32x4 va = xs[2 * j], vb = xs[2 * j + 1];
                    const float o[8] = {va[0], va[1], va[2], va[3], vb[0], vb[1], vb[2], vb[3]}; *(u32x4*)(p.xn() + (size_t)tk * D + k) = pack8(o); } }
            continue;
        }
        float lg[4], le[32];
#pragma unroll
        for (int j = 0; j < 4; ++j) lg[j] = 0.f;
#pragma unroll
        for (int j = 0; j < 32; ++j) le[j] = 0.f;
        const float* wg = p.moe_w_grp + (size_t)layer * D * 4; const float* we = p.moe_w_exp + (size_t)layer * D * 32;
#pragma unroll 1
        for (int i = 0; i < 16; ++i) { const int k0 = 64 * i + 4 * kq; const f32x4 x = ld4bf(hbr + k0), g = *(const f32x4*)(gain + k0), s1 = *(const f32x4*)(sc + k0), s0 = *(const f32x4*)(sh + k0);
            const f32x4 xv = (x * rstd * g) * (s1 + 1.0f) + s0; *(u32x2*)(p.xn() + (size_t)tk * D + k0) = pack4bf(xv);
#pragma unroll
            for (int e = 0; e < 4; ++e) { const int k = k0 + e; const float v = xv[e]; const f32x4 g4 = *(const f32x4*)(wg + k * 4);
#pragma unroll
                for (int j = 0; j < 4; ++j) lg[j] += v * g4[j];
#pragma unroll
                for (int q = 0; q < 8; ++q) { const f32x4 e4 = *(const f32x4*)(we + k * 32 + q * 4);
#pragma unroll
                    for (int j = 0; j < 4; ++j) le[q * 4 + j] += v * e4[j]; } } }
#pragma unroll
        for (int j = 0; j < 4; ++j) { RED16(lg[j]) lg[j] += p.moe_b_grp[layer * 4 + j]; }
#pragma unroll
        for (int j = 0; j < 32; ++j) { RED16(le[j]) le[j] += p.moe_b_exp[layer * 32 + j]; }
        if (kq == 0 && !(dry && lg[0] != 12345.678f)) {
            int gi = 0; float gm = lg[0];
#pragma unroll
            for (int j = 1; j < 4; ++j) if (lg[j] > gm) { gm = lg[j]; gi = j; }
            float gz = 0.f;
#pragma unroll
            for (int j = 0; j < 4; ++j) gz += expf(lg[j] - gm);
            const float pg = 1.0f / gz;
            float es[8];
#pragma unroll
            for (int j = 0; j < 8; ++j) es[j] = gi == 0 ? le[j] : gi == 1 ? le[8 + j] : gi == 2 ? le[16 + j] : le[24 + j];
            int i1 = 0; float e1 = es[0];
#pragma unroll
            for (int j = 1; j < 8; ++j) if (es[j] > e1) { e1 = es[j]; i1 = j; }
            int i2 = -1; float e2 = -3.0e38f;
#pragma unroll
            for (int j = 0; j < 8; ++j) if (j != i1 && es[j] > e2) { e2 = es[j]; i2 = j; }
            const float r = expf(e2 - e1), inv = 1.0f / (1.0f + r);
            const int ea = gi * 8 + i1, eb = gi * 8 + i2;
            p.eidx()[tk * 2 + 0] = ea; p.eidx()[tk * 2 + 1] = eb; p.ew()[tk * 2 + 0] = pg * inv; p.ew()[tk * 2 + 1] = pg * r * inv;
            const int pa = atomicAdd(p.mcnt() + layer * 32 + ea, 1); p.mlist()[(size_t)ea * (T * 2) + pa] = tk * 2;
            const int pb = atomicAdd(p.mcnt() + layer * 32 + eb, 1); p.mlist()[(size_t)eb * (T * 2) + pb] = tk * 2 + 1;
        }
    }
}

DEVNI void bk_norm_router(const Params& p, unsigned char* lds, int layer, int t0, bool dry) {
    const int tid = TIDX, lane = tid & 63, wave = tid >> 6, tl = lane & 15, kc = lane >> 4;
    const float* gain = p.norm2_g + (size_t)layer * D; float* ssp = (float*)lds; float* lg = (float*)lds + 64; float* lgs = lg + 4 * 768;
    const bf16_t* whi = p.wr_hi() + (size_t)layer * 48 * D; const bf16_t* wlo = p.wr_lo() + (size_t)layer * 48 * D;
    for (int gi0 = blockIdx.x; gi0 < (T - t0) / 16; gi0 += gridDim.x) {
        const int tk = t0 + gi0 * 16 + tl; const bf16_t* h = hrow(p, tk) + wave * 256;
        u32x4 hw8[8]; float ss = 0.f;
#pragma unroll
        for (int ks = 0; ks < 8; ++ks) hw8[ks] = *(const u32x4*)(h + 32 * ks + 8 * kc);
#pragma unroll
        for (int ks = 0; ks < 8; ++ks) { float hv[8]; unpack8(hw8[ks], hv);
            ss += ((hv[0] * hv[0] + hv[1] * hv[1]) + (hv[2] * hv[2] + hv[3] * hv[3])) + ((hv[4] * hv[4] + hv[5] * hv[5]) + (hv[6] * hv[6] + hv[7] * hv[7])); }
        ss += SHFL_XOR(ss, 16); ss = SUM_XOR32(ss);
        __syncthreads();
        if (lane < 16) ssp[wave * 16 + lane] = ss;
        __syncthreads();
        const float rstd = rsqrtf(((ssp[tl] + ssp[16 + tl]) + (ssp[32 + tl] + ssp[48 + tl])) / D + EPS);
        const int mr = modrow(tk); const float* sh = modp(p, layer, mr, 3); const float* sc = modp(p, layer, mr, 4);
        f32x4 acc[3];
#pragma unroll
        for (int nt = 0; nt < 3; ++nt) acc[nt] = (f32x4){0.f, 0.f, 0.f, 0.f};
#pragma unroll
        for (int ks = 0; ks < 8; ++ks) { const int k = wave * 256 + 32 * ks + 8 * kc; float hv[8], xv[8], xl[8]; unpack8(hw8[ks], hv);
#pragma unroll
            for (int q = 0; q < 2; ++q) { const f32x4 x = (f32x4){hv[4 * q], hv[4 * q + 1], hv[4 * q + 2], hv[4 * q + 3]}, g = *(const f32x4*)(gain + k + 4 * q), s1 = *(const f32x4*)(sc + k + 4 * q), s0 = *(const f32x4*)(sh + k + 4 * q);
                const f32x4 v = (x * rstd * g) * (s1 + 1.0f) + s0; xv[4 * q] = v[0]; xv[4 * q + 1] = v[1]; xv[4 * q + 2] = v[2]; xv[4 * q + 3] = v[3]; }
            const u32x4 hw = pack8(xv); *(u32x4*)(p.xn() + (size_t)tk * D + k) = hw;
            float xh[8]; unpack8(hw, xh);
#pragma unroll
            for (int e = 0; e < 8; ++e) xl[e] = xv[e] - xh[e];
            const bf16x8 ahi = __builtin_bit_cast(bf16x8, hw), alo = __builtin_bit_cast(bf16x8, pack8(xl));
#pragma unroll
            for (int nt = 0; nt < 3; ++nt) { const bf16x8 bhi = *(const bf16x8*)(whi + (size_t)(nt * 16 + tl) * D + k), blo = *(const bf16x8*)(wlo + (size_t)(nt * 16 + tl) * D + k);
                acc[nt] = MFMA16(ahi, bhi, acc[nt]); acc[nt] = MFMA16(ahi, blo, acc[nt]); acc[nt] = MFMA16(alo, bhi, acc[nt]); }
        }
#pragma unroll
        for (int nt = 0; nt < 3; ++nt)
#pragma unroll
            for (int r = 0; r < 4; ++r) lg[(wave * 16 + kc * 4 + r) * 48 + nt * 16 + tl] = acc[nt][r];
        __syncthreads();
#pragma unroll
        for (int q = 0; q < 3; ++q) { const int idx = tid + 256 * q; lgs[idx] = (lg[idx] + lg[768 + idx]) + (lg[1536 + idx] + lg[2304 + idx]); }
        __syncthreads();
        if (tid < 16) {
            const int tkk = t0 + gi0 * 16 + tid; const float* my = lgs + tid * 48;
            float l4[4];
#pragma unroll
            for (int j = 0; j < 4; ++j) l4[j] = my[j] + p.moe_b_grp[layer * 4 + j];
            int gi = 0; float gm = l4[0];
#pragma unroll
            for (int j = 1; j < 4; ++j) if (l4[j] > gm) { gm = l4[j]; gi = j; }
            float gz = 0.f;
#pragma unroll
            for (int j = 0; j < 4; ++j) gz += expf(l4[j] - gm);
            const float pg = 1.0f / gz;
            float es[8];
#pragma unroll
            for (int j = 0; j < 8; ++j) es[j] = my[4 + gi * 8 + j] + p.moe_b_exp[layer * 32 + gi * 8 + j];
            int i1 = 0; float e1 = es[0];
#pragma unroll
            for (int j = 1; j < 8; ++j) if (es[j] > e1) { e1 = es[j]; i1 = j; }
            int i2 = -1; float e2 = -3.0e38f;
#pragma unroll
            for (int j = 0; j < 8; ++j) if (j != i1 && es[j] > e2) { e2 = es[j]; i2 = j; }
            const float r = expf(e2 - e1), inv = 1.0f / (1.0f + r);
            const int ea = gi * 8 + i1, eb = gi * 8 + i2;
            if (!(dry && gm != 12345.678f)) {
                p.eidx()[tkk * 2 + 0] = ea; p.eidx()[tkk * 2 + 1] = eb; p.ew()[tkk * 2 + 0] = pg * inv; p.ew()[tkk * 2 + 1] = pg * r * inv;
                const int pa = atomicAdd(p.mcnt() + layer * 32 + ea, 1); p.mlist()[(size_t)ea * (T * 2) + pa] = tkk * 2;
                const int pb = atomicAdd(p.mcnt() + layer * 32 + eb, 1); p.mlist()[(size_t)eb * (T * 2) + pb] = tkk * 2 + 1;
            }
        }
    }
}

DEVNI void bk_feat1(const Params& p) {
    const int tid = TIDX, lane = tid & 63, wave = tid >> 6;
    for (int it = blockIdx.x; it < T / 4; it += gridDim.x) {
        const int tk = it * 4 + wave; int pos, len; if (tk < TC) { pos = tk % NC; len = NC; } else { pos = (tk - TC) % NL; len = NL; }
        const bool hasp = pos > 0, hasn = pos < len - 1;
#pragma unroll
        for (int i = 0; i < 4; ++i) {
            const int c8 = lane + 64 * i;
            if (c8 >= 244) { if (c8 < 248) *(u32x4*)(p.lin() + (size_t)tk * LIN_LD + (c8 - 192) * 8) = (u32x4){0u, 0u, 0u, 0u}; continue; }
            const int col = c8 * 8; float y[8], pv[8], nx[8], sv[8];
            unpack8(*(const u32x4*)(p.prw() + (size_t)tk * SHIFT_W + col), y);
            if (hasp) unpack8(*(const u32x4*)(p.prw() + (size_t)(tk - 1) * SHIFT_W + col), pv); else { for (int e = 0; e < 8; ++e) pv[e] = 0.f; }
            if (hasn) unpack8(*(const u32x4*)(p.prw() + (size_t)(tk + 1) * SHIFT_W + col), nx); else { for (int e = 0; e < 8; ++e) nx[e] = 0.f; }
            { const f32x4 m0a = *(const f32x4*)(p.ev_shift_mu + col), m0b = *(const f32x4*)(p.ev_shift_mu + col + 4), m1a = *(const f32x4*)(p.ev_shift_mu + SHIFT_W + col), m1b = *(const f32x4*)(p.ev_shift_mu + SHIFT_W + col + 4);
              const float mu0[8] = {m0a[0], m0a[1], m0a[2], m0a[3], m0b[0], m0b[1], m0b[2], m0b[3]}, mu1[8] = {m1a[0], m1a[1], m1a[2], m1a[3], m1b[0], m1b[1], m1b[2], m1b[3]};
#pragma unroll
              for (int e = 0; e < 8; ++e) sv[e] = y[e] + mu0[e] * (pv[e] - y[e]) + mu1[e] * (nx[e] - y[e]); }
            if (i == 0) *(u32x4*)(p.fr() + (size_t)tk * 512 + col) = pack8(sv);
            else if (i == 1) { const int c = col - 512; float n2 = 0.f;
                { const f32x4 ka = *(const f32x4*)(p.rwkv_k_k + c), kb = *(const f32x4*)(p.rwkv_k_k + c + 4); const float kk8[8] = {ka[0], ka[1], ka[2], ka[3], kb[0], kb[1], kb[2], kb[3]};
#pragma unroll
                  for (int e = 0; e < 8; ++e) { sv[e] *= kk8[e]; n2 += sv[e] * sv[e]; } }
                RED8(n2)
                const float nrm = fmaxf(sqrtf(n2), 1e-12f), inv = 1.0f / nrm;
#pragma unroll
                for (int e = 0; e < 8; ++e) sv[e] *= inv;
                *(u32x4*)(p.fkk() + (size_t)tk * 512 + c) = pack8(sv);
                if ((lane & 7) == 0) p.fnrm()[(size_t)tk * 8 + (c >> 6)] = nrm; }
            else if (i == 2) *(u32x4*)(p.fv() + (size_t)tk * 512 + (col - 1024)) = pack8(sv);
            else { const int j8 = c8 - 192;
#pragma unroll
                for (int e = 0; e < 8; ++e) sv[e] = j8 < 16 ? (2.0f * fast_sigmoid(2.0f * sv[e]) - 1.0f) : j8 < 32 ? sv[e] : fast_sigmoid(sv[e]);
                *(u32x4*)(p.lin() + (size_t)tk * LIN_LD + j8 * 8) = pack8(sv); }
        }
    }
}
DEVNI void bk_feat2(const Params& p, unsigned char* lds) {
    constexpr int NTM = T / GBM;
    for (int it = blockIdx.x; it < 5 * NTM * 4; it += gridDim.x) {
        const int g = it / (NTM * 4), mt = it % NTM, nt = (it / NTM) % 4;
        if (g < 2) {
            bf16_t* omw = g ? p.fomw1() : p.fomw0();
            gemm_tile<true>(lds, plainA(p.lin() + g * 64, LIN_LD), mt * GBM, p.wt_w2() + (size_t)g * 512 * 64, 64, nt * GBN, 64, [&](f32x4 (&acc)[4][4], int mb, int nb, int fr, int fq) {
                f32x4 w0v[4];
#pragma unroll
                for (int ni = 0; ni < 4; ++ni) w0v[ni] = *(const f32x4*)(p.rwkv_w0 + g * 512 + nb + ni * 16 + fq * 4);
#pragma unroll
                for (int mi = 0; mi < 4; ++mi)
#pragma unroll
                    for (int np = 0; np < 2; ++np) { const int row = mb + mi * 16 + fr; u32x2 pk[2];
#pragma unroll
                        for (int e = 0; e < 2; ++e) { const int ni = 2 * np + e, col = nb + ni * 16 + fq * 4; f32x4 v;
#pragma unroll
                            for (int r = 0; r < 4; ++r) { const float sg = fast_sigmoid(w0v[ni][r] + acc[mi][ni][r]);
                                v[r] = 1.0f - FAST_EXP2(-0.8750612633917001f * sg); }
                            pk[e] = pack4bf(v); }
                        st16_pair(omw + (size_t)row * 512 + nb + np * 32, fq, pk[0], pk[1]); }
            });
        } else if (g < 4) {
            const int d = g - 2; bf16_t* kka = d ? p.fkka1() : p.fkka0(); bf16_t* kt = d ? p.fkt1() : p.fkt0();
            gemm_tile<true>(lds, plainA(p.lin() + 128 + d * 64, LIN_LD), mt * GBM, p.wt_a2() + (size_t)d * 512 * 64, 64, nt * GBN, 64, [&](f32x4 (&acc)[4][4], int mb, int nb, int fr, int fq) {
                f32x4 a0v[4], rkk[4], kav[4];
#pragma unroll
                for (int ni = 0; ni < 4; ++ni) { const int c = nb + ni * 16 + fq * 4; a0v[ni] = *(const f32x4*)(p.rwkv_a0 + d * 512 + c); const f32x4 kk4 = *(const f32x4*)(p.rwkv_k_k + c); kav[ni] = *(const f32x4*)(p.rwkv_k_a + c);
                    rkk[ni] = (f32x4){1.0f / kk4[0], 1.0f / kk4[1], 1.0f / kk4[2], 1.0f / kk4[3]}; }
#pragma unroll
                for (int mi = 0; mi < 4; ++mi)
#pragma unroll
                    for (int np = 0; np < 2; ++np) { const int row = mb + mi * 16 + fr; u32x2 pa[2], pt[2];
#pragma unroll
                        for (int e = 0; e < 2; ++e) { const int ni = 2 * np + e, col = nb + ni * 16 + fq * 4; const u32x2 kw = *(const u32x2*)(p.fkk() + (size_t)row * 512 + col);
                            const float kkv[4] = {__builtin_bit_cast(float, kw.x << 16), __builtin_bit_cast(float, kw.x & 0xffff0000u), __builtin_bit_cast(float, kw.y << 16), __builtin_bit_cast(float, kw.y & 0xffff0000u)};
                            const float nrm = p.fnrm()[(size_t)row * 8 + (col >> 6)]; f32x4 va, vt;
#pragma unroll
                            for (int r = 0; r < 4; ++r) { const float a = fast_sigmoid(a0v[ni][r] + acc[mi][ni][r]); va[r] = kkv[r] * a;
                                vt[r] = kkv[r] * (nrm * rkk[ni][r]) * (1.0f + (a - 1.0f) * kav[ni][r]); }
                            pa[e] = pack4bf(va); pt[e] = pack4bf(vt); }
                        st16_pair(kka + (size_t)row * 512 + nb + np * 32, fq, pa[0], pa[1]); st16_pair(kt + (size_t)row * 512 + nb + np * 32, fq, pt[0], pt[1]); }
            });
        } else {
            gemm_tile<true>(lds, plainA(p.lin() + 256, LIN_LD), mt * GBM, p.wt_g2(), 192, nt * GBN, 192, [&](f32x4 (&acc)[4][4], int mb, int nb, int fr, int fq) {
#pragma unroll
                for (int mi = 0; mi < 4; ++mi)
#pragma unroll
                    for (int np = 0; np < 2; ++np) { const int row = mb + mi * 16 + fr; st16_pair(p.fgate() + (size_t)row * 512 + nb + np * 32, fq, pack4bf(acc[mi][2 * np]), pack4bf(acc[mi][2 * np + 1])); }
            });
        }
    }
}
DEVNI void bk_mixout(const Params& p) {
    const int tid = TIDX, lane = tid & 63, wave = tid >> 6;
    float rk8[8], lw8[8], lb8[8];
    { const int c = lane * 8; const f32x4 a0 = *(const f32x4*)(p.rwkv_r_k + c), a1 = *(const f32x4*)(p.rwkv_r_k + c + 4), b0 = *(const f32x4*)(p.rwkv_lnx_w + c), b1 = *(const f32x4*)(p.rwkv_lnx_w + c + 4), c0 = *(const f32x4*)(p.rwkv_lnx_b + c), c1 = *(const f32x4*)(p.rwkv_lnx_b + c + 4);
#pragma unroll
      for (int e = 0; e < 4; ++e) { rk8[e] = a0[e]; rk8[4 + e] = a1[e]; lw8[e] = b0[e]; lw8[4 + e] = b1[e]; lb8[e] = c0[e]; lb8[4 + e] = c1[e]; } }
    for (int it = blockIdx.x; it < T / 4; it += gridDim.x) {
        const int tk = it * 4 + wave, c = lane * 8; const size_t o = (size_t)tk * 512 + c;
        float y[8], r[8], k0[8], k1[8], v[8], g[8];
        { float ya[8], yb2[8]; unpack8(*(const u32x4*)(p.yf() + o), ya); unpack8(*(const u32x4*)(p.ybw() + o), yb2);
#pragma unroll
          for (int e = 0; e < 8; ++e) y[e] = ya[e] + yb2[e]; }
        unpack8(*(const u32x4*)(p.fr() + o), r); unpack8(*(const u32x4*)(p.fkt0() + o), k0); unpack8(*(const u32x4*)(p.fkt1() + o), k1); unpack8(*(const u32x4*)(p.fv() + o), v); unpack8(*(const u32x4*)(p.fgate() + o), g);
        float mu = 0.f, bn = 0.f;
#pragma unroll
        for (int e = 0; e < 8; ++e) { mu += y[e]; bn += r[e] * (k0[e] + k1[e]) * rk8[e]; }
        RED8(mu) RED8(bn)
        mu *= (1.0f / 64.f); float var = 0.f;
#pragma unroll
        for (int e = 0; e < 8; ++e) { const float d = y[e] - mu; var += d * d; }
        RED8(var)
        const float rs = rsqrtf(var * (1.0f / 64.f) + GN_EPS); float ov[8];
#pragma unroll
        for (int e = 0; e < 8; ++e) ov[e] = ((y[e] - mu) * rs * lw8[e] + lb8[e] + bn * v[e]) * g[e];
        *(u32x4*)(p.mixw() + o) = pack8(ov);
    }
}
DEVNI void bk_mlanorm(const Params& p) {
    const int tid = TIDX, lane = tid & 63, wave = tid >> 6;
    for (int it = blockIdx.x; it < T / 4; it += gridDim.x) {
        const int tk = it * 4 + wave; const bf16_t* a = p.qkva() + (size_t)tk * 704;
        const f32x4 q0 = ld4bf(a + 4 * lane); f32x4 q1 = (f32x4){0.f, 0.f, 0.f, 0.f}; if (lane < 32) q1 = ld4bf(a + 256 + 4 * lane);
        const f32x4 kv = ld4bf(a + 384 + 4 * lane);
        float s1 = (q0[0] * q0[0] + q0[1] * q0[1]) + (q0[2] * q0[2] + q0[3] * q0[3]) + (q1[0] * q1[0] + q1[1] * q1[1]) + (q1[2] * q1[2] + q1[3] * q1[3]);
        float s2 = (kv[0] * kv[0] + kv[1] * kv[1]) + (kv[2] * kv[2] + kv[3] * kv[3]);
        RED64(s1) RED64(s2)
        const float r1 = rsqrtf(s1 / 384.f + EPS), r2 = rsqrtf(s2 / 256.f + EPS);
        *(u32x2*)(p.cq() + (size_t)tk * 384 + 4 * lane) = pack4bf(q0 * r1 * *(const f32x4*)(p.mla_q_norm_g + 4 * lane));
        if (lane < 32) *(u32x2*)(p.cq() + (size_t)tk * 384 + 256 + 4 * lane) = pack4bf(q1 * r1 * *(const f32x4*)(p.mla_q_norm_g + 256 + 4 * lane));
        *(u32x2*)(p.ckv() + (size_t)tk * 256 + 4 * lane) = pack4bf(kv * r2 * *(const f32x4*)(p.mla_kv_norm_g + 4 * lane));
        f32x4 pe = (f32x4){0.f, 0.f, 0.f, 0.f}; if (lane < 16) pe = ld4bf(a + 640 + 4 * lane);
        f32x4 pr; pr[0] = SHFL_XOR(pe[0], 4); pr[1] = SHFL_XOR(pe[1], 4); pr[2] = SHFL_XOR(pe[2], 4); pr[3] = SHFL_XOR(pe[3], 4);
        if (lane < 16) {
            f32x4 o = pe;
            if (tk >= TC) { const int t = (tk - TC) % NL, hf = lane >> 3, pos = hf ? (t % 64) : (t / 64); const bool up = (lane & 4) != 0;
#pragma unroll
                for (int e = 0; e < 4; ++e) { const int i = (lane & 3) * 4 + e; const float cs = p.ropetab()[(pos * 16 + i) * 2], sn = p.ropetab()[(pos * 16 + i) * 2 + 1];
                    o[e] = up ? (pe[e] * cs + pr[e] * sn) : (pe[e] * cs - pr[e] * sn); } }
            *(u32x2*)(p.kpe() + (size_t)tk * 64 + 4 * lane) = pack4bf(o);
        }
    }
}


#ifndef HOST_EMU
#define XB_TMO      128
#define XB_XCNT(j)  (256  + 64 * (j))
#define XB_XSUB(j)  (1280 + 64 * (j))
#define XB_XGEN(j)  (2304 + 64 * (j))
#define XB_TOP      3328
#define XB_TOPGEN   3392
#define XCD_BAR_WORDS 3456
#define XB_SPIN_CAP (1u << 22)
#define LAS __attribute__((address_space(3)))
__device__ __forceinline__ unsigned xb_ld(unsigned* p)              { return __hip_atomic_load(p, __ATOMIC_RELAXED, __HIP_MEMORY_SCOPE_AGENT); }
__device__ __forceinline__ unsigned xb_add(unsigned* p, unsigned v) { return __hip_atomic_fetch_add(p, v, __ATOMIC_RELAXED, __HIP_MEMORY_SCOPE_AGENT); }
__device__ __forceinline__ unsigned xb_xcc_id() { return (unsigned)__builtin_amdgcn_s_getreg((3 << 11) | 20) & 0xFu; }
#define XB_SPIN(cond, bar) do { unsigned _sp = 0; while (cond) { if (_sp > 96u) __builtin_amdgcn_s_sleep(24); else __builtin_amdgcn_s_sleep(1);     \
    if ((++_sp & 255u) == 0u) { if (xb_ld(&(bar)[XB_TMO])) break; if (_sp > XB_SPIN_CAP) { atomicAdd(&(bar)[XB_TMO], 1u); break; } } } } while (0)
struct XcdBarrier { unsigned* bar; unsigned x; volatile LAS unsigned* st; };
__device__ __forceinline__ XcdBarrier xcd_barrier_post(unsigned* bar, volatile LAS unsigned* st) {
    XcdBarrier b; b.bar = bar; b.x = xb_xcc_id(); b.st = st;
    if (threadIdx.x == 0) (void)xb_add(&bar[XB_XCNT(b.x)], 1u);
    return b;
}
__device__ __forceinline__ void xcd_barrier_complete(unsigned* bar, unsigned x, unsigned& nloc, unsigned& nx) {
    const unsigned G = gridDim.x * gridDim.y * gridDim.z;
    unsigned sum, cnt, mine, sp = 0u;
    for (;;) {
        sum = 0u; cnt = 0u; mine = 0u;
#pragma unroll
        for (unsigned j = 0; j < 16; ++j) { const unsigned c = xb_ld(&bar[XB_XCNT(j)]); sum += c; cnt += (c > 0u) ? 1u : 0u; mine = (j == x) ? c : mine; }
        if (sum == G) break;
        __builtin_amdgcn_s_sleep(1);
        if ((++sp & 255u) == 0u) { if (xb_ld(&bar[XB_TMO])) break; if (sp > XB_SPIN_CAP) { atomicAdd(&bar[XB_TMO], 1u); break; } }
    }
    nloc = mine > 0u ? mine : 1u; nx = cnt > 0u ? cnt : 1u;
}
__device__ __forceinline__ void xcd_barrier(const XcdBarrier& b) {
    asm volatile("s_waitcnt vmcnt(0)" ::: "memory");
    __syncthreads();
    if (threadIdx.x == 0) {
        unsigned* bar = b.bar;
        __builtin_amdgcn_s_waitcnt(0);
        unsigned nloc = b.st[0], nx = b.st[1];
        if (nloc == 0u) { xcd_barrier_complete(bar, b.x, nloc, nx); b.st[0] = nloc; b.st[1] = nx; }
        const unsigned old = xb_add(&bar[XB_XSUB(b.x)], 1u);
        const unsigned gen = old / nloc;
        if (old + 1u == (gen + 1u) * nloc) {
            __builtin_amdgcn_fence(__ATOMIC_RELEASE, "agent");
            asm volatile("s_waitcnt vmcnt(0)" ::: "memory");
            const unsigned og = xb_add(&bar[XB_TOP], 1u);
            const unsigned tg = og / nx;
            if (og + 1u == (tg + 1u) * nx) xb_add(&bar[XB_TOPGEN], 1u);
            else XB_SPIN(xb_ld(&bar[XB_TOPGEN]) == tg, bar);
            __builtin_amdgcn_fence(__ATOMIC_ACQUIRE, "agent");
            xb_add(&bar[XB_XGEN(b.x)], 1u);
            asm volatile("s_waitcnt vmcnt(0)" ::: "memory");
        } else {
            XB_SPIN(xb_ld(&bar[XB_XGEN(b.x)]) == gen, bar);
            __builtin_amdgcn_fence(__ATOMIC_ACQUIRE, "agent");
            asm volatile("s_waitcnt vmcnt(0)" ::: "memory");
        }
    }
    __syncthreads();
}
#endif

enum { BK_CONV_DENSE, BK_CONV_MOE, BK_EVIN, BK_WOUT, BK_WO, BK_MLAIN, BK_UQ, BK_UKV, BK_MOEH, BK_MOED, BK_UQROPE, BK_UKVS, BK_ATTN, BK_RETD, BK_RETP, BK_RETO, BK_RWKV, BK_MOD, BK_NORM01, BK_NORM02, BK_NORM11, BK_NORM12, BK_FINAL, BK_FEAT1, BK_FEAT2, BK_MIXOUT, BK_MLANORM, BK_NORM02D, BK_EMPTY, BK_RWKVQ, BK_RWKVP, BK_RWKVC, BK_UQ_UKV, BK_PROLOGUE, BK_RETD_FEAT1, BK_RWKV_CONV, BK_NORM11_CONV };
template <int PH> DEVFN void run_bphase(const Params& p, unsigned char* lds, int a0) {
    if constexpr (PH == BK_CONV_DENSE) bk_convert_dense(p, lds);
    else if constexpr (PH == BK_CONV_MOE) bk_convert_moe(p, lds, a0);
    else if constexpr (PH == BK_EVIN) bk_evin(p, lds);
    else if constexpr (PH == BK_WOUT) bk_wout(p, lds);
    else if constexpr (PH == BK_WO) bk_wo(p, lds);
    else if constexpr (PH == BK_MLAIN) bk_mlain(p, lds);
    else if constexpr (PH == BK_MOEH) bk_moe_stream<true>(p, lds, a0);
    else if constexpr (PH == BK_MOED) bk_moe_stream<false>(p, lds, a0);
    else if constexpr (PH == BK_UQROPE) bk_uq_rope(p, lds);
    else if constexpr (PH == BK_UKVS) bk_ukv_split(p, lds);
    else if constexpr (PH == BK_ATTN) bk_attn(p, lds);
    else if constexpr (PH == BK_RETD) bk_ret_delta(p, lds);
    else if constexpr (PH == BK_RETP) bk_ret_prefix(p, lds);
    else if constexpr (PH == BK_RETO) bk_ret_out(p, lds);
    else if constexpr (PH == BK_RWKV) bk_rwkv_scan(p, lds);
    else if constexpr (PH == BK_MOD) bk_mod(p, lds);
    else if constexpr (PH == BK_NORM01) bk_norm(p, 0, 1, 0);
    else if constexpr (PH == BK_NORM02) bk_norm_router(p, lds, 0, 0, false);
    else if constexpr (PH == BK_NORM11) bk_norm(p, 1, 1, 0);
    else if constexpr (PH == BK_NORM12) bk_norm_router(p, lds, 1, TC, false);
    else if constexpr (PH == BK_FINAL) bk_norm(p, 1, 3, TC);
    else if constexpr (PH == BK_FEAT1) bk_feat1(p);
    else if constexpr (PH == BK_FEAT2) bk_feat2(p, lds);
    else if constexpr (PH == BK_MIXOUT) bk_mixout(p);
    else if constexpr (PH == BK_MLANORM) bk_mlanorm(p);
    else if constexpr (PH == BK_NORM02D) bk_norm_router(p, lds, 0, 0, true);
    else if constexpr (PH == BK_UQ_UKV) { bk_ukv_split(p, lds); bk_uq_rope(p, lds); }
    else if constexpr (PH == BK_RWKVP) bk_rwkv_chunk2<0>(p, lds);
    else if constexpr (PH == BK_RWKVC) bk_rwkv_chunk<0>(p, lds);
    else if constexpr (PH == BK_RWKVQ) { bk_rwkv_chunk3(p, lds); if (GRIDX >= 512) bk_convert_moe(p, lds, 0, 256); }
    else if constexpr (PH == BK_PROLOGUE) { bk_mod(p, lds); bk_convert_dense(p, lds); if (GRIDX < 512) bk_convert_moe(p, lds, 0); }
    else if constexpr (PH == BK_RETD_FEAT1) { bk_ret_delta(p, lds); bk_feat1(p); }
    else if constexpr (PH == BK_RWKV_CONV) { bk_ret_out(p, lds); }
    else if constexpr (PH == BK_NORM11_CONV) { bk_norm(p, 1, 1, 0); bk_convert_moe(p, lds, 1); }
}
#define FORWARD_PROGRAM(X, XB, XB0, CK) \
    XB0(BK_PROLOGUE, 0) \
    XB(BK_NORM01, 0) XB(BK_EVIN, 0) XB(BK_RETD_FEAT1, 0) XB(BK_RETP, 0) XB(BK_RWKV_CONV, 0) XB(BK_FEAT2, 0) \
    XB(BK_RWKVQ, 0) XB(BK_MIXOUT, 0) XB(BK_WOUT, 0) CK("mix0") \
    XB(BK_NORM02, 0) XB(BK_MOEH, 0) XB(BK_MOED, 0) CK("moe0") \
    XB(BK_NORM11_CONV, 0) XB(BK_MLAIN, 0) XB(BK_MLANORM, 0) XB(BK_UQ_UKV, 0) XB(BK_ATTN, 0) \
    XB(BK_WO, 0) CK("mix1") \
    XB(BK_NORM12, 0) XB(BK_MOEH, 1) XB(BK_MOED, 1) CK("moe1") \
    XB(BK_FINAL, 0)

#ifndef HOST_EMU
#define MEGA_XB(PH, a0) run_bphase<PH>(p, lds, a0); { XcdBarrier xb_; xb_.bar = p.bar(); xb_.x = xb_xcc_id(); xb_.st = (volatile LAS unsigned*)&xb_words; xcd_barrier(xb_); }
#define MEGA_XB0(PH, a0) if (p.cg_sync) grid.sync(); MEGA_XB(PH, a0)
#define MEGA_CK(name)
__global__ void __launch_bounds__(256, 2) mega_kernel(Params p) {
    cg::grid_group grid = cg::this_grid();
    LDS_ARRAY(lds, LDS_BYTES);
    __shared__ uint4 xb_words;
    if (threadIdx.x == 0) xb_words = make_uint4(0u, 0u, 0u, 0u);
    __syncthreads();
    (void)xcd_barrier_post(p.bar(), (volatile LAS unsigned*)&xb_words);
    FORWARD_PROGRAM(0, MEGA_XB, MEGA_XB0, MEGA_CK)
}
#else
void emu_checkpoint(const char* name, const Params& p);
#ifndef EMU_GRID
#define EMU_GRID 16
#endif
#define EMU_XB(PH, a0) emu_launch(EMU_GRID, 256, [&]() { LDS_ARRAY(lds_, LDS_BYTES); run_bphase<PH>(p, lds_, a0); });
#define EMU_CK(name) emu_checkpoint(name, p);
#endif

extern "C" void kernel_launch(void* const* d_in, const int* in_sizes, int n_in, void* d_out, int out_size, void* d_ws, size_t ws_size, hipStream_t stream) {
    (void)in_sizes; (void)n_in; (void)out_size;
    if (WL.total > ws_size) { fprintf(stderr, "workspace too small: need %zu have %zu\n", (size_t)WL.total, ws_size); return; }
    Params p{};
    const float* const* in = (const float* const*)d_in;
    p.x = in[0]; p.c = in[1]; p.ctx = in[2]; p.c_ctx = in[3]; p.ada_w = in[4]; p.ada_b = in[5]; p.norm1_g = in[6]; p.norm2_g = in[7]; p.final_g = in[8];
    p.ev_w_in = in[9]; p.ev_shift_mu = in[10]; p.rwkv_w0 = in[11]; p.rwkv_w2 = in[12]; p.rwkv_a0 = in[13]; p.rwkv_a2 = in[14]; p.rwkv_g2 = in[15];
    p.rwkv_k_k = in[16]; p.rwkv_k_a = in[17]; p.rwkv_r_k = in[18]; p.rwkv_lnx_w = in[19]; p.rwkv_lnx_b = in[20]; p.ev_w_out = in[21];
    p.mla_w_in = in[22]; p.mla_q_norm_g = in[23]; p.mla_w_uq = in[24]; p.mla_kv_norm_g = in[25]; p.mla_w_ukv = in[26]; p.mla_w_o = in[27];
    p.moe_w_grp = in[28]; p.moe_b_grp = in[29]; p.moe_w_exp = in[30]; p.moe_b_exp = in[31]; p.moe_w_gate = in[32]; p.moe_w_up = in[33]; p.moe_w_down = in[34];
    p.out = (float*)d_out; p.ws = (char*)d_ws; p.cg_sync = 0; p.pad_ = 0;
#ifdef HOST_EMU
    FORWARD_PROGRAM(0, EMU_XB, EMU_XB, EMU_CK)
#else
    static int grid_blocks = 0;
    if (!grid_blocks) {
        int dev = 0, cus = 0, per_cu = 0;
        (void)hipGetDevice(&dev); (void)hipDeviceGetAttribute(&cus, hipDeviceAttributeMultiprocessorCount, dev);
        (void)hipOccupancyMaxActiveBlocksPerMultiprocessor(&per_cu, mega_kernel, 256, 0);
        if (per_cu > 2) per_cu = 2;
        grid_blocks = cus * per_cu;
    }
    (void)hipMemsetAsync(d_ws, 0, 16384, stream);
    void* args[] = {&p};
    hipError_t e = hipLaunchCooperativeKernel((void*)mega_kernel, dim3(grid_blocks), dim3(256), args, 0, stream);
    if (e != hipSuccess) fprintf(stderr, "cooperative launch failed: %s (grid %d)\n", hipGetErrorString(e), grid_blocks);
#endif
}
```
